# Optimizing an MI355X kernel written in HIP

```python
import math
import jax, jax.numpy as jnp
from jax import lax
import numpy as np

D_MODEL = 1024
BATCH = 8
SEQ = 2048
DEPTH = 1

CHUNK = 64
Q_BLOCK = 128
N_MEM = 256
N_DIFF_HEADS = 4
DIFF_V_DIM = D_MODEL // 2 // N_DIFF_HEADS
DIFF_QK_DIM = DIFF_V_DIM // 2
N_FOX_HEADS = 4
FOX_HEAD_DIM = D_MODEL // 2 // N_FOX_HEADS
N_CROSS_HEADS = 4
CROSS_HEAD_DIM = D_MODEL // N_CROSS_HEADS
N_BUCKETS = 32
MAX_DISTANCE = 128
N_GROUPS = 4
EXPERTS_PER_GROUP = 4
N_EXPERTS = N_GROUPS * EXPERTS_PER_GROUP
TOP_K_IN_GROUP = 2
D_EXPERT = D_MODEL // 2
FORGET_BIAS_INIT = 2.0
EPS = 1e-6
NEG_INF = -1e30

DIFF_WIDTH = N_DIFF_HEADS * DIFF_V_DIM
FOX_WIDTH = N_FOX_HEADS * FOX_HEAD_DIM
MIX_WIDTH = DIFF_WIDTH + FOX_WIDTH
COL_SIZES = [
    N_DIFF_HEADS * 2 * DIFF_QK_DIM,
    N_DIFF_HEADS * 2 * DIFF_QK_DIM,
    DIFF_WIDTH,
    FOX_WIDTH,
    FOX_WIDTH,
    FOX_WIDTH,
    N_FOX_HEADS,
]
IN_COLS = sum(COL_SIZES)
SPLITS = [int(v) for v in np.cumsum(COL_SIZES)[:-1]]

kernel_name = "hybrid_diff_fox_memxattn_hmoe"


def rms_norm(x, g):
    xf = x.astype(jnp.float32)
    y = xf * lax.rsqrt(jnp.mean(xf * xf, axis=-1, keepdims=True) + EPS)
    return (y * g.astype(jnp.float32)).astype(x.dtype)


def t5_bucket(rel):
    nb = N_BUCKETS // 2
    max_exact = nb // 2
    ret = (rel > 0).astype(jnp.int32) * nb
    n = jnp.abs(rel)
    nf = jnp.maximum(n, 1).astype(jnp.float32)
    large = max_exact + (jnp.log(nf / max_exact) / math.log(MAX_DISTANCE / max_exact)
                         * (nb - max_exact)).astype(jnp.int32)
    large = jnp.minimum(large, nb - 1)
    return ret + jnp.where(n < max_exact, n, large)


def differential_attention(q, k, v, rel_bias, lam, lam_init, subln_g):
    s_len = q.shape[1]
    scale = DIFF_QK_DIM ** -0.5
    pos = jnp.arange(s_len, dtype=jnp.int32)
    chunk = pos // CHUNK
    outs = []
    for i in range(s_len // Q_BLOCK):
        q0, q1 = i * Q_BLOCK, (i + 1) * Q_BLOCK
        logits = jnp.einsum('bqhcd,bkhcd->bhcqk', q[:, q0:q1], k[:, :q1]).astype(jnp.float32) * scale
        rel = pos[None, :q1] - pos[q0:q1, None]
        bias = jnp.transpose(rel_bias[t5_bucket(rel)], (2, 0, 1)).astype(jnp.float32)
        mask = chunk[None, :q1] <= chunk[q0:q1, None]
        logits = jnp.where(mask, logits + bias[None, :, None], NEG_INF)
        probs = jax.nn.softmax(logits, axis=-1)
        attn = probs[:, :, 0] - lam * probs[:, :, 1]
        outs.append(jnp.einsum('bhqk,bkhe->bqhe', attn.astype(v.dtype), v[:, :q1]))
    o = jnp.concatenate(outs, axis=1)
    return rms_norm(o, subln_g) * (1.0 - lam_init)


def forgetting_attention(q, k, v, cum_logf, out_g):
    s_len = q.shape[1]
    scale = FOX_HEAD_DIM ** -0.5
    pos = jnp.arange(s_len, dtype=jnp.int32)
    outs = []
    for i in range(s_len // Q_BLOCK):
        q0, q1 = i * Q_BLOCK, (i + 1) * Q_BLOCK
        logits = jnp.einsum('bqhd,bkhd->bhqk', q[:, q0:q1], k[:, :q1]).astype(jnp.float32) * scale
        decay = cum_logf[:, :, q0:q1, None] - cum_logf[:, :, None, :q1]
        mask = pos[None, :q1] <= pos[q0:q1, None]
        logits = jnp.where(mask, logits + decay, NEG_INF)
        probs = jax.nn.softmax(logits, axis=-1)
        outs.append(jnp.einsum('bhqk,bkhd->bqhd', probs.astype(v.dtype), v[:, :q1]))
    o = jnp.concatenate(outs, axis=1)
    return rms_norm(o, out_g)


def memory_cross_attention(h, mem_n, w_cq, w_ckv, q_g, k_g, w_co):
    b, s_len, _ = h.shape
    q = (h @ w_cq).reshape(b, s_len, N_CROSS_HEADS, CROSS_HEAD_DIM)
    kv = (mem_n @ w_ckv).reshape(b, mem_n.shape[1], 2, N_CROSS_HEADS, CROSS_HEAD_DIM)
    q = rms_norm(q, q_g)
    k = rms_norm(kv[:, :, 0], k_g)
    v = kv[:, :, 1]
    logits = jnp.einsum('bshd,bmhd->bhsm', q, k).astype(jnp.float32) * CROSS_HEAD_DIM ** -0.5
    probs = jax.nn.softmax(logits, axis=-1)
    o = jnp.einsum('bhsm,bmhd->bshd', probs.astype(v.dtype), v)
    return o.reshape(b, s_len, D_MODEL) @ w_co


def hierarchical_moe(h, w_gr, b_gr, w_er, b_er, w_gate, w_up, w_down):
    b, s_len, d = h.shape
    t = h.reshape(-1, d)
    n_tok = t.shape[0]
    p_group = jax.nn.softmax((t @ w_gr + b_gr).astype(jnp.float32), axis=-1)
    g_idx = jnp.argmax(p_group, axis=-1)
    p_g = jnp.take_along_axis(p_group, g_idx[:, None], axis=-1)
    e_logits = (t @ w_er + b_er).astype(jnp.float32).reshape(n_tok, N_GROUPS, EXPERTS_PER_GROUP)
    sel = jnp.take_along_axis(e_logits, g_idx[:, None, None], axis=1)[:, 0]
    p_in = jax.nn.softmax(sel, axis=-1)
    top_v, top_i = lax.top_k(p_in, TOP_K_IN_GROUP)
    top_v = top_v / jnp.sum(top_v, axis=-1, keepdims=True)
    w = p_g * top_v
    eid = g_idx[:, None] * EXPERTS_PER_GROUP + top_i
    gates = jnp.sum(jax.nn.one_hot(eid, N_EXPERTS, dtype=jnp.float32) * w[..., None], axis=1)
    gates = gates.astype(t.dtype)
    y = jnp.zeros_like(t)
    for e in range(N_EXPERTS):
        a = jax.nn.silu(t @ w_gate[e]) * (t @ w_up[e])
        y = y + gates[:, e:e + 1] * (a @ w_down[e])
    return y.reshape(b, s_len, d)


def setup_inputs(seed: int = 0) -> dict:
    key = jax.random.key(seed)
    ks = iter(jax.random.split(key, 48))
    L, D = DEPTH, D_MODEL

    def nrm(shape, scale):
        return scale * jax.random.normal(next(ks), shape, jnp.float32)

    def gain(shape):
        return 1.0 + nrm(shape, 0.02)

    return {
        "x": nrm((BATCH, SEQ, D), 1.0),
        "mem": nrm((BATCH, N_MEM, D), 1.0),
        "rel_bias": nrm((N_BUCKETS, N_DIFF_HEADS), 0.5),
        "norm_mix_g": gain((L, D)),
        "w_in": nrm((L, D, IN_COLS), D ** -0.5),
        "b_forget": FORGET_BIAS_INIT + nrm((L, N_FOX_HEADS), 0.1),
        "diff_q_norm_g": gain((L, DIFF_QK_DIM)),
        "diff_k_norm_g": gain((L, DIFF_QK_DIM)),
        "diff_lambda_q1": nrm((L, DIFF_QK_DIM), 0.1),
        "diff_lambda_k1": nrm((L, DIFF_QK_DIM), 0.1),
        "diff_lambda_q2": nrm((L, DIFF_QK_DIM), 0.1),
        "diff_lambda_k2": nrm((L, DIFF_QK_DIM), 0.1),
        "diff_subln_g": gain((L, DIFF_V_DIM)),
        "fox_q_norm_g": gain((L, FOX_HEAD_DIM)),
        "fox_k_norm_g": gain((L, FOX_HEAD_DIM)),
        "fox_out_norm_g": gain((L, FOX_HEAD_DIM)),
        "w_out": nrm((L, MIX_WIDTH, D), MIX_WIDTH ** -0.5),
        "norm_cross_g": gain((L, D)),
        "norm_mem_g": gain((L, D)),
        "w_cq": nrm((L, D, D), D ** -0.5),
        "w_ckv": nrm((L, D, 2 * D), D ** -0.5),
        "cross_q_norm_g": gain((L, CROSS_HEAD_DIM)),
        "cross_k_norm_g": gain((L, CROSS_HEAD_DIM)),
        "w_co": nrm((L, D, D), D ** -0.5),
        "norm_ffn_g": gain((L, D)),
        "w_group_router": nrm((L, D, N_GROUPS), D ** -0.5),
        "b_group_router": nrm((L, N_GROUPS), 0.01),
        "w_expert_router": nrm((L, D, N_EXPERTS), D ** -0.5),
        "b_expert_router": nrm((L, N_EXPERTS), 0.01),
        "w_exp_gate": nrm((L, N_EXPERTS, D, D_EXPERT), D ** -0.5),
        "w_exp_up": nrm((L, N_EXPERTS, D, D_EXPERT), D ** -0.5),
        "w_exp_down": nrm((L, N_EXPERTS, D_EXPERT, D), D_EXPERT ** -0.5),
    }


def reference(x, mem, rel_bias, norm_mix_g, w_in, b_forget, diff_q_norm_g, diff_k_norm_g,
              diff_lambda_q1, diff_lambda_k1, diff_lambda_q2, diff_lambda_k2, diff_subln_g,
              fox_q_norm_g, fox_k_norm_g, fox_out_norm_g, w_out, norm_cross_g, norm_mem_g,
              w_cq, w_ckv, cross_q_norm_g, cross_k_norm_g, w_co, norm_ffn_g,
              w_group_router, b_group_router, w_expert_router, b_expert_router,
              w_exp_gate, w_exp_up, w_exp_down):
    b, s_len, _ = x.shape
    for l in range(DEPTH):
        h = rms_norm(x, norm_mix_g[l])
        proj = h @ w_in[l]
        dq, dk, dv, fq, fk, fv, f_logit = jnp.split(proj, SPLITS, axis=-1)
        dq = rms_norm(dq.reshape(b, s_len, N_DIFF_HEADS, 2, DIFF_QK_DIM), diff_q_norm_g[l])
        dk = rms_norm(dk.reshape(b, s_len, N_DIFF_HEADS, 2, DIFF_QK_DIM), diff_k_norm_g[l])
        dv = dv.reshape(b, s_len, N_DIFF_HEADS, DIFF_V_DIM)
        lam_init = 0.8 - 0.6 * math.exp(-0.3 * l)
        lam = (jnp.exp(jnp.sum(diff_lambda_q1[l].astype(jnp.float32) * diff_lambda_k1[l].astype(jnp.float32)))
               - jnp.exp(jnp.sum(diff_lambda_q2[l].astype(jnp.float32) * diff_lambda_k2[l].astype(jnp.float32)))
               + lam_init)
        o_diff = differential_attention(dq, dk, dv, rel_bias, lam, lam_init, diff_subln_g[l])

        fq = rms_norm(fq.reshape(b, s_len, N_FOX_HEADS, FOX_HEAD_DIM), fox_q_norm_g[l])
        fk = rms_norm(fk.reshape(b, s_len, N_FOX_HEADS, FOX_HEAD_DIM), fox_k_norm_g[l])
        fv = fv.reshape(b, s_len, N_FOX_HEADS, FOX_HEAD_DIM)
        log_f = jax.nn.log_sigmoid(f_logit.astype(jnp.float32) + b_forget[l].astype(jnp.float32))
        cum_logf = jnp.transpose(jnp.cumsum(log_f, axis=1), (0, 2, 1))
        o_fox = forgetting_attention(fq, fk, fv, cum_logf, fox_out_norm_g[l])

        mixed = jnp.concatenate([o_diff.reshape(b, s_len, DIFF_WIDTH),
                                 o_fox.reshape(b, s_len, FOX_WIDTH)], axis=-1)
        x = x + mixed @ w_out[l]

        x = x + memory_cross_attention(rms_norm(x, norm_cross_g[l]), rms_norm(mem, norm_mem_g[l]),
                                       w_cq[l], w_ckv[l], cross_q_norm_g[l], cross_k_norm_g[l], w_co[l])

        x = x + hierarchical_moe(rms_norm(x, norm_ffn_g[l]), w_group_router[l], b_group_router[l],
                                 w_expert_router[l], b_expert_router[l],
                                 w_exp_gate[l], w_exp_up[l], w_exp_down[l])
    return x
```

```cpp
#include <hip/hip_runtime.h>
#include <cstdio>
#include <cstdint>
namespace pg8 {
#define PG8_LAS __attribute__((address_space(3)))
typedef unsigned short bf16_t;
typedef short bf16x8 __attribute__((ext_vector_type(8)));
typedef float f32x4 __attribute__((ext_vector_type(4)));
typedef unsigned u32x4 __attribute__((ext_vector_type(4)));
constexpr int BM = 256, BK = 64, HALF = 128, HTB = HALF * BK * 2  , STAGE_BYTES = 8 * HTB, NXCD = 8, WGM = 8;

__host__ __device__ __forceinline__ int lds_byte(int r, int c) { const int st = (r >> 4) * 2 + (c >> 5), rr = r & 15, cc = c & 31, ob = rr * 64 + cc * 2; return st * 1024 + (ob ^ (((ob >> 9) & 1) << 5)); }
__host__ __device__ __forceinline__ void stage_rc(int b, int& R, int& C) { const int st = b / 1024, sb = b % 1024, swz = sb ^ (((sb >> 9) & 1) << 5); R = (st >> 1) * 16 + swz / 64; C = (st & 1) * 32 + (swz % 64) / 2; }
__host__ __device__ __forceinline__ int perm32(int rho) { const int n = rho >> 4, i = rho & 15; return 8 * (i >> 2) + 4 * n + (i & 3); }

struct Unit { int pm, pn; };
struct Gemm { const bf16_t* A; const bf16_t* Bt; int M, N, K; };

struct StaticOrder {
    int nM, nN, nwg, G, c;
    __host__ __device__ void init(int M, int N, int G_, int c_) { nM = M / BM; nN = N / BM; nwg = nM * nN; G = G_; c = c_; }
    __host__ __device__ bool next(int i, Unit& u) const {
        const long L = (long)i * G + c; if (L >= nwg) return false;
        int wgid = (int)L; { const int q = nwg / NXCD, r = nwg % NXCD, xcd = wgid % NXCD, off = wgid / NXCD; wgid = (xcd < r ? xcd * (q + 1) : r * (q + 1) + (xcd - r) * q) + off; }
        const int nig = WGM * nN, gid = wgid / nig, fm = gid * WGM, gsz = (nM - fm) < WGM ? (nM - fm) : WGM;
        u.pm = fm + ((wgid % nig) % gsz); u.pn = (wgid % nig) / gsz; return true;
    }
    __device__ __forceinline__ void a_ready(const Unit&) const {}
    __device__ __forceinline__ void done(const Unit&) const {}
};

__device__ __forceinline__ unsigned cvt_pk_bf16(float lo, float hi) { unsigned r; asm volatile("v_cvt_pk_bf16_f32 %0, %1, %2" : "=v"(r) : "v"(lo), "v"(hi)); return r; }
template <class Epi, class Sched, bool ALIGN_EPI = false, bool SP2 = false>
__device__ __forceinline__ void gemm_phase(PG8_LAS unsigned char* lds, const Gemm g, const Sched& S, const Epi& E) {
    const int tid = threadIdx.x, wid = __builtin_amdgcn_readfirstlane(tid >> 6), lane = tid & 63, wr = wid >> 2, wc = wid & 3, fr = lane & 15, fq = lane >> 4;
    const int K = g.K, nt = K / BK;
    unsigned voffA[2], voffB[2];
#pragma unroll
    for (int i = 0; i < 2; ++i) { int R, C; stage_rc(tid * 16 + i * 8192, R, C); const int Rb = Epi::PERM ? ((R & ~31) + perm32(R & 31)) : R;
        voffA[i] = (unsigned)(R * K + C) * 2u; voffB[i] = (unsigned)(Rb * K + C) * 2u; }
    const size_t kstep = (size_t)(BK * 2);
    const size_t hstep = (size_t)HALF * K * 2;
    const size_t tstep = 2 * hstep;
    const unsigned ldsw = (unsigned)wid * 1024u;
    const int aoff = lds_byte(wr * 64 + fr, fq * 8), boff = lds_byte(wc * 32 + fr, fq * 8);
#define PG8_SA(b, h) (((b) * 2 + (h)) * HTB)
#define PG8_SB(b, h) ((4 + (b) * 2 + (h)) * HTB)
#define PG8_STAGE(bufoff, gbase, voff) do { _Pragma("unroll") for (int _i = 0; _i < 2; ++_i) \
        __builtin_amdgcn_global_load_lds((const unsigned*)((const char*)(gbase) + (voff)[_i]), (PG8_LAS unsigned*)(lds + (bufoff) + ldsw + _i * 8192), 16, 0, 0); } while (0)
#define PG8_LDA(dst, b, h) do { _Pragma("unroll") for (int m = 0; m < 4; ++m) _Pragma("unroll") for (int k = 0; k < 2; ++k) dst[m][k] = *(const PG8_LAS bf16x8*)(lds + PG8_SA(b, h) + aoff + m * 2048 + k * 1024); } while (0)
#define PG8_LDB(dst, b, h) do { _Pragma("unroll") for (int n = 0; n < 2; ++n) _Pragma("unroll") for (int k = 0; k < 2; ++k) dst[n][k] = *(const PG8_LAS bf16x8*)(lds + PG8_SB(b, h) + boff + n * 2048 + k * 1024); } while (0)
#define PG8_MMA(ai, bj, At, Bt) do { __builtin_amdgcn_s_setprio(1); _Pragma("unroll") for (int m = 0; m < 4; ++m) _Pragma("unroll") for (int n = 0; n < 2; ++n) _Pragma("unroll") for (int k = 0; k < 2; ++k) \
        acc[ai][bj][m][n] = __builtin_amdgcn_mfma_f32_16x16x32_bf16(Bt[n][k], At[m][k], acc[ai][bj][m][n], 0, 0, 0); __builtin_amdgcn_s_setprio(0); } while (0)
#define PG8_WAIT_V(n) asm volatile("s_waitcnt vmcnt(" #n ")" ::: "memory")
#define PG8_WAIT_L(n) asm volatile("s_waitcnt lgkmcnt(" #n ")" ::: "memory")
#define PG8_BAR __builtin_amdgcn_s_barrier()
#define PG8_SCHED __builtin_amdgcn_sched_barrier(0)
    Unit cur, nxt; int ui = 0;
    if (!S.next(0, cur)) return;
    f32x4 acc[2][2][4][2];
#pragma unroll
    for (int a = 0; a < 2; ++a)
#pragma unroll
        for (int b = 0; b < 2; ++b)
#pragma unroll
            for (int m = 0; m < 4; ++m)
#pragma unroll
                for (int n = 0; n < 2; ++n) acc[a][b][m][n] = (f32x4){0.f, 0.f, 0.f, 0.f};
    bf16x8 At[4][2], B0[2][2], B1[2][2];
    const char* cA = (const char*)g.A + (size_t)cur.pm * tstep; const char* cB = (const char*)g.Bt + (size_t)cur.pn * tstep;
    S.a_ready(cur);
    if constexpr (SP2) {
        PG8_STAGE(PG8_SB(0, 0), cB, voffB); PG8_STAGE(PG8_SB(0, 1), cB + hstep, voffB); PG8_STAGE(PG8_SA(0, 0), cA, voffA); PG8_STAGE(PG8_SA(0, 1), cA + hstep, voffA);
        if (wr == 1) PG8_BAR;
        PG8_WAIT_V(2); PG8_BAR;
        PG8_STAGE(PG8_SB(1, 0), cB + kstep, voffB); PG8_STAGE(PG8_SA(1, 0), cA + kstep, voffA); PG8_STAGE(PG8_SB(1, 1), cB + hstep + kstep, voffB);
        PG8_WAIT_V(6); PG8_BAR;
    } else {
        PG8_STAGE(PG8_SB(0, 0), cB, voffB); PG8_STAGE(PG8_SA(0, 0), cA, voffA); PG8_STAGE(PG8_SB(0, 1), cB + hstep, voffB); PG8_STAGE(PG8_SA(0, 1), cA + hstep, voffA);
        if (wr == 1) PG8_BAR;
        PG8_WAIT_V(4); PG8_BAR;
        PG8_STAGE(PG8_SB(1, 0), cB + kstep, voffB); PG8_STAGE(PG8_SA(1, 0), cA + kstep, voffA); PG8_STAGE(PG8_SB(1, 1), cB + hstep + kstep, voffB);
        PG8_WAIT_V(6); PG8_BAR;
    }
    for (;;) {
        const bool has_next = S.next(ui + 1, nxt);
        const char* nA = has_next ? (const char*)g.A + (size_t)nxt.pm * tstep : cA; const char* nB = has_next ? (const char*)g.Bt + (size_t)nxt.pn * tstep : cB;
        for (int t = 0; t < nt; t += 2) {
            const bool last = (t == nt - 2);
            const char* a1 = cA + (size_t)(t + 1) * kstep;
            const char* a2 = last ? nA : cA + (size_t)(t + 2) * kstep; const char* b2 = last ? nB : cB + (size_t)(t + 2) * kstep;
            const char* a3 = a2 + kstep; const char* b3 = b2 + kstep;
            if (last && has_next) S.a_ready(nxt);
            if constexpr (SP2) {
            PG8_LDB(B0, 0, 0); PG8_LDB(B1, 0, 1); PG8_SCHED; PG8_LDA(At, 0, 0); PG8_STAGE(PG8_SA(1, 1), a1 + hstep, voffA);
            PG8_WAIT_V(8); PG8_WAIT_L(0); PG8_BAR; PG8_MMA(0, 0, At, B0); PG8_MMA(0, 1, At, B1); PG8_BAR; PG8_SCHED;
            PG8_LDA(At, 0, 1); PG8_STAGE(PG8_SB(0, 0), b2, voffB); PG8_STAGE(PG8_SB(0, 1), b2 + hstep, voffB); PG8_STAGE(PG8_SA(0, 0), a2, voffA);
            PG8_WAIT_V(8); PG8_WAIT_L(0); PG8_BAR; PG8_MMA(1, 0, At, B0); PG8_MMA(1, 1, At, B1); PG8_BAR; PG8_SCHED;
            PG8_LDB(B0, 1, 0); PG8_LDB(B1, 1, 1); PG8_SCHED; PG8_LDA(At, 1, 0); PG8_STAGE(PG8_SA(0, 1), a2 + hstep, voffA);
            PG8_WAIT_V(8); PG8_WAIT_L(0); PG8_BAR; PG8_MMA(0, 0, At, B0); PG8_MMA(0, 1, At, B1); PG8_BAR; PG8_SCHED;
            PG8_LDA(At, 1, 1); PG8_STAGE(PG8_SB(1, 0), b3, voffB); PG8_STAGE(PG8_SB(1, 1), b3 + hstep, voffB); PG8_STAGE(PG8_SA(1, 0), a3, voffA);
            PG8_WAIT_V(8); PG8_WAIT_L(0); PG8_BAR; PG8_MMA(1, 0, At, B0); PG8_MMA(1, 1, At, B1); PG8_BAR; PG8_SCHED;
            } else {
            PG8_LDB(B0, 0, 0); PG8_SCHED; PG8_LDA(At, 0, 0); PG8_STAGE(PG8_SA(1, 1), a1 + hstep, voffA);
            PG8_WAIT_L(8); PG8_BAR; PG8_WAIT_L(0); PG8_MMA(0, 0, At, B0); PG8_BAR; PG8_SCHED;
            PG8_LDB(B1, 0, 1); PG8_STAGE(PG8_SB(0, 0), b2, voffB);
            PG8_BAR; PG8_WAIT_L(0); PG8_MMA(0, 1, At, B1); PG8_BAR;
            PG8_LDA(At, 0, 1); PG8_STAGE(PG8_SA(0, 0), a2, voffA);
            PG8_BAR; PG8_WAIT_L(0); PG8_MMA(1, 0, At, B0); PG8_BAR; PG8_SCHED;
            PG8_STAGE(PG8_SB(0, 1), b2 + hstep, voffB);
            PG8_WAIT_V(6); PG8_BAR; PG8_MMA(1, 1, At, B1); PG8_BAR;
            PG8_LDB(B0, 1, 0); PG8_SCHED; PG8_LDA(At, 1, 0); PG8_STAGE(PG8_SA(0, 1), a2 + hstep, voffA);
            PG8_WAIT_L(8); PG8_BAR; PG8_WAIT_L(0); PG8_MMA(0, 0, At, B0); PG8_BAR; PG8_SCHED;
            PG8_LDB(B1, 1, 1); PG8_STAGE(PG8_SB(1, 0), b3, voffB);
            PG8_BAR; PG8_WAIT_L(0); PG8_MMA(0, 1, At, B1); PG8_BAR;
            PG8_LDA(At, 1, 1); PG8_STAGE(PG8_SA(1, 0), a3, voffA);
            PG8_BAR; PG8_WAIT_L(0); PG8_MMA(1, 0, At, B0); PG8_BAR; PG8_SCHED;
            PG8_STAGE(PG8_SB(1, 1), b3 + hstep, voffB);
            PG8_WAIT_V(6); PG8_BAR; PG8_MMA(1, 1, At, B1); PG8_BAR;
            }
        }
        if constexpr (ALIGN_EPI) { if (wr == 0) PG8_BAR; }
        if constexpr (!Epi::AFTER_DRAIN) { E(acc, cur, wr, wc, fr, fq); S.done(cur); }
        if (!has_next) break;
#pragma unroll
        for (int a = 0; a < 2; ++a)
#pragma unroll
            for (int b = 0; b < 2; ++b)
#pragma unroll
                for (int m = 0; m < 4; ++m)
#pragma unroll
                    for (int n = 0; n < 2; ++n) acc[a][b][m][n] = (f32x4){0.f, 0.f, 0.f, 0.f};
        cur = nxt; cA = nA; cB = nB; ++ui;
        if constexpr (ALIGN_EPI) { if (wr == 1) PG8_BAR; }
    }
    PG8_WAIT_V(0);
    if constexpr (!ALIGN_EPI) { if (wr == 0) PG8_BAR; }
    PG8_BAR;
    if constexpr (Epi::AFTER_DRAIN) { E.fused(acc, cur, wr, wc, fr, fq, lds, wid, lane); S.done(cur); }
#undef PG8_SA
#undef PG8_SB
#undef PG8_STAGE
#undef PG8_LDA
#undef PG8_LDB
#undef PG8_MMA
#undef PG8_WAIT_V
#undef PG8_WAIT_L
#undef PG8_BAR
#undef PG8_SCHED
}
}
namespace pg8 {
struct EpiBf16SS {
    static constexpr bool PERM = true, AFTER_DRAIN = false;
    bf16_t* O; int ldc; float* SS; int ssld; unsigned ssmask;
    __device__ __forceinline__ void operator()(const f32x4 (&acc)[2][2][4][2], const Unit& u, int wr, int wc, int fr, int fq) const {
        const int row0 = u.pm * BM + wr * 64 + fr, col0 = u.pn * BM + wc * 32 + 8 * fq;
        const bool doss = ((ssmask >> u.pn) & 1u) != 0u;
#pragma unroll
        for (int ai = 0; ai < 2; ++ai)
#pragma unroll
            for (int m = 0; m < 4; ++m) { const int row = row0 + ai * HALF + m * 16; bf16_t* rowp = O + (size_t)row * ldc + col0;
#pragma unroll
                for (int bj = 0; bj < 2; ++bj) { const f32x4 v0 = acc[ai][bj][m][0], v1 = acc[ai][bj][m][1];
                    u32x4 w; w.x = cvt_pk_bf16(v0[0], v0[1]); w.y = cvt_pk_bf16(v0[2], v0[3]); w.z = cvt_pk_bf16(v1[0], v1[1]); w.w = cvt_pk_bf16(v1[2], v1[3]);
                    *(u32x4*)(rowp + bj * HALF) = w;
                    if (doss) { float s = (v0[0] * v0[0] + v0[1] * v0[1]) + (v0[2] * v0[2] + v0[3] * v0[3]) + (v1[0] * v1[0] + v1[1] * v1[1]) + (v1[2] * v1[2] + v1[3] * v1[3]);
                        s += __shfl_xor(s, 16); s += __shfl_xor(s, 32);
                        if (fq == 0) SS[(size_t)row * ssld + ((u.pn * BM + bj * HALF + wc * 32) >> 5)] = s; } } }
    }
};
struct EpiResF32 {
    static constexpr bool PERM = false, AFTER_DRAIN = false;
    const float* base; float* out; int ldc;
    __device__ __forceinline__ void operator()(const f32x4 (&acc)[2][2][4][2], const Unit& u, int wr, int wc, int fr, int fq) const {
        const int col0 = u.pn * BM + wc * 32 + 4 * fq;
#pragma unroll
        for (int ai = 0; ai < 2; ++ai)
#pragma unroll
            for (int m = 0; m < 4; ++m) { const size_t off = (size_t)(u.pm * BM + ai * HALF + wr * 64 + m * 16 + fr) * ldc + col0;
#pragma unroll
                for (int bj = 0; bj < 2; ++bj)
#pragma unroll
                    for (int n = 0; n < 2; ++n) { const f32x4 bs = *(const f32x4*)(base + off + bj * HALF + n * 16); *(f32x4*)(out + off + bj * HALF + n * 16) = bs + acc[ai][bj][m][n]; }
                if (m & 1) asm volatile("" ::: "memory"); }
    }
};
struct EpiMoe1 {
    static constexpr bool PERM = true, AFTER_DRAIN = false;
    bf16_t* ACT; int ldc;
    __device__ __forceinline__ void operator()(const f32x4 (&acc)[2][2][4][2], const Unit& u, int wr, int wc, int fr, int fq) const {
        const int row0 = u.pm * BM + wr * 64 + fr, col0 = (u.pn & 3) * HALF + wc * 32 + 8 * fq;
#pragma unroll
        for (int ai = 0; ai < 2; ++ai)
#pragma unroll
            for (int m = 0; m < 4; ++m) { float a[8];
#pragma unroll
                for (int n = 0; n < 2; ++n)
#pragma unroll
                    for (int e = 0; e < 4; ++e) { const float g = acc[ai][0][m][n][e], up = acc[ai][1][m][n][e]; a[n * 4 + e] = g * __builtin_amdgcn_rcpf(1.0f + __expf(-g)) * up; }
                u32x4 w; w.x = cvt_pk_bf16(a[0], a[1]); w.y = cvt_pk_bf16(a[2], a[3]); w.z = cvt_pk_bf16(a[4], a[5]); w.w = cvt_pk_bf16(a[6], a[7]);
                *(u32x4*)(ACT + (size_t)(row0 + ai * HALF + m * 16) * ldc + col0) = w; }
    }
};
struct EpiMoe2 {
    static constexpr bool PERM = false, AFTER_DRAIN = false;
    float* out; int ldc; const int* slot_tok; const float* slot_w; const int* seg;
    __device__ __forceinline__ void operator()(const f32x4 (&acc)[2][2][4][2], const Unit& u, int wr, int wc, int fr, int fq) const {
        const int e = u.pn >> 2, send = seg[2 * e] + seg[2 * e + 1];
        const int col0 = (u.pn & 3) * BM + wc * 32 + 4 * fq;
#pragma unroll
        for (int ai = 0; ai < 2; ++ai)
#pragma unroll
            for (int m = 0; m < 4; ++m) { const int slot = u.pm * BM + ai * HALF + wr * 64 + m * 16 + fr;
                if (slot < send) { const int tok = slot_tok[slot]; const float w = slot_w[slot]; float* op = out + (size_t)tok * ldc + col0;
#pragma unroll
                    for (int bj = 0; bj < 2; ++bj)
#pragma unroll
                        for (int n = 0; n < 2; ++n)
#pragma unroll
                            for (int q = 0; q < 4; ++q) unsafeAtomicAdd(op + bj * HALF + n * 16 + q, w * acc[ai][bj][m][n][q]); } }
    }
};
struct MoeOrder {
    int ntile, G, c; const PG8_LAS int* tile_e;
    __device__ __forceinline__ bool next(int i, Unit& u) const {
        const int L = i * G + c; if (L >= ntile * 4) return false;
        const int ti = L >> 2; u.pm = ti; u.pn = __builtin_amdgcn_readfirstlane(tile_e[ti]) * 4 + (L & 3); return true;
    }
    __device__ __forceinline__ void a_ready(const Unit&) const {}
    __device__ __forceinline__ void done(const Unit&) const {}
};
}
namespace att {
#define ALAS __attribute__((address_space(3)))
typedef unsigned short bf16_t;
typedef short bf16x8 __attribute__((ext_vector_type(8)));
typedef short s16x4 __attribute__((ext_vector_type(4)));
typedef float f32x16 __attribute__((ext_vector_type(16)));
typedef float f32x4 __attribute__((ext_vector_type(4)));
typedef unsigned u32x4 __attribute__((ext_vector_type(4)));
enum { FOX = 0, DIFF = 1, CROSS = 2 };
constexpr int SUBT = 16384;
constexpr float LOG2E = 1.4426950408889634f, NEPS = 1e-6f, THR = 8.f;
constexpr int SEQ = 2048, PROJW = 3072, DM = 1024, NMEM = 256;
constexpr int BT_N = 320, BT_OFF = 224;

template <int T> struct AC;
template <> struct AC<FOX>   { static constexpr int NKS = 8,  ROWS = 256, KSUB = 1, VSUB = 1; };
template <> struct AC<DIFF>  { static constexpr int NKS = 4,  ROWS = 128, KSUB = 1, VSUB = 1; };
template <> struct AC<CROSS> { static constexpr int NKS = 16, ROWS = 128, KSUB = 2, VSUB = 2; };

__device__ __forceinline__ int kswz(int row, int colB) { return row * 256 + (colB ^ ((row & 7) << 4)); }
__device__ __forceinline__ int v_st(int k, int c) { const int kk = (k & ~0xC) | ((k & 4) << 1) | ((k & 8) >> 1); return ((kk >> 3) * 4 + (c >> 5)) * 512 + ((kk & 7) * 32 + (c & 31)) * 2; }
__device__ __forceinline__ int v_rd_base(int lane) { return ((lane & 3) << 3) | (((lane >> 2) & 3) << 6) | (((lane >> 4) & 1) << 5) | (((lane >> 5) & 1) << 8); }
__device__ __forceinline__ int crow(int r, int hi) { return (r & 3) + 8 * (r >> 2) + 4 * hi; }
__device__ __forceinline__ unsigned cvtpk(float lo, float hi) { unsigned r; asm volatile("v_cvt_pk_bf16_f32 %0, %1, %2" : "=v"(r) : "v"(lo), "v"(hi)); return r; }
__device__ __forceinline__ float bflo(unsigned w) { return __uint_as_float(w << 16); }
__device__ __forceinline__ float bfhi(unsigned w) { return __uint_as_float(w & 0xffff0000u); }
#define ASBAR() __builtin_amdgcn_sched_barrier(0)

__device__ __forceinline__ bf16x8 qprep(u32x4 raw, float s, const ALAS float* G) {
    const f32x4 g0 = *(const ALAS f32x4*)G, g1 = *(const ALAS f32x4*)(G + 4);
    u32x4 w;
    w.x = cvtpk(bflo(raw.x) * s * g0[0], bfhi(raw.x) * s * g0[1]); w.y = cvtpk(bflo(raw.y) * s * g0[2], bfhi(raw.y) * s * g0[3]);
    w.z = cvtpk(bflo(raw.z) * s * g1[0], bfhi(raw.z) * s * g1[1]); w.w = cvtpk(bflo(raw.w) * s * g1[2], bfhi(raw.w) * s * g1[3]);
    return __builtin_bit_cast(bf16x8, w);
}

struct Ptrs {
    const bf16_t* PROJ;  const float* SS;
    const float* NEGC;
    const bf16_t* QC;    const float* SSQC;
    const bf16_t* KVC;   const float* SSKV;
    bf16_t* MIX;         bf16_t* CO;
    const float* g_fox_out; const float* g_subln;
    float lam, one_m_lam_init;
};

template <int T> constexpr int tilesz() { return (AC<T>::KSUB + AC<T>::VSUB) * SUBT; }
constexpr int KT_OFF_SELF = 65536, KT_OFF_CROSS = 131072;
__device__ __forceinline__ void dma16(const void* g, ALAS unsigned char* l) { __builtin_amdgcn_global_load_lds((const unsigned*)g, (ALAS unsigned*)l, 16, 0, 0); }
template <int T>
__device__ __forceinline__ void attn_unit(const Ptrs& P, int b, int h, int blk, ALAS unsigned char* lds, ALAS float* wsf, const ALAS float* GQ, const ALAS float* BT) {
    constexpr int NKS = AC<T>::NKS, ROWS = AC<T>::ROWS, KSUB = AC<T>::KSUB, VSUB = AC<T>::VSUB, BUFSZ = tilesz<T>();
    constexpr int KT_OFF = (T == CROSS) ? KT_OFF_CROSS : KT_OFF_SELF, STG_OFF = (T == CROSS) ? 0 : 65536;
    int tid_ = threadIdx.x; asm volatile("" : "+v"(tid_));
    const int tid = tid_, wid = __builtin_amdgcn_readfirstlane(tid >> 6), lane = tid & 63, r32 = lane & 31, hi = lane >> 5;
    const int rg = (T == FOX) ? wid : (wid & 3), sel = (T == FOX) ? 0 : (wid >> 2);
    const int P0 = blk * ROWS, qlo = P0 + 32 * rg;
    const int NT = (T == CROSS) ? NMEM / 64 : (P0 + ROWS) / 64;
    const bf16_t* Kp; const bf16_t* Vp; int kvpitch; const float* SSk; int sskld;
    if constexpr (T == FOX)  { Kp = P.PROJ + (size_t)b * SEQ * PROJW + 2048 + h * 128; Vp = Kp + 512; kvpitch = PROJW; SSk = P.SS + (size_t)b * SEQ * 96 + 64 + 4 * h; sskld = 96; }
    if constexpr (T == DIFF) { Kp = P.PROJ + (size_t)b * SEQ * PROJW + 512 + h * 128;  Vp = Kp + 512; kvpitch = PROJW; SSk = P.SS + (size_t)b * SEQ * 96 + 16 + 4 * h; sskld = 96; }
    if constexpr (T == CROSS){ Kp = P.KVC + (size_t)b * NMEM * 2048 + h * 256;         Vp = Kp + 1024; kvpitch = 2048; SSk = P.SSKV + (size_t)b * NMEM * 64 + 8 * h; sskld = 64; }
    ALAS float* KT = (ALAS float*)(lds + KT_OFF);
    for (int k = tid; k < NT * 64; k += 512) {
        const f32x4 s4 = *(const f32x4*)(SSk + (size_t)k * sskld);
        if constexpr (T == FOX)   { KT[k] = __builtin_amdgcn_rsqf(((s4[0] + s4[1]) + (s4[2] + s4[3])) * (1.f / 128.f) + NEPS); KT[2048 + k] = P.NEGC[(size_t)(b * 4 + h) * SEQ + k]; }
        if constexpr (T == DIFF)  { KT[k] = __builtin_amdgcn_rsqf((s4[0] + s4[1]) * (1.f / 64.f) + NEPS); KT[2048 + k] = __builtin_amdgcn_rsqf((s4[2] + s4[3]) * (1.f / 64.f) + NEPS); }
        if constexpr (T == CROSS) { const f32x4 s5 = *(const f32x4*)(SSk + (size_t)k * sskld + 4); KT[k] = __builtin_amdgcn_rsqf((((s4[0] + s4[1]) + (s4[2] + s4[3])) + ((s5[0] + s5[1]) + (s5[2] + s5[3]))) * (1.f / 256.f) + NEPS); }
    }
    int koff[2], voff[2];
#pragma unroll
    for (int i = 0; i < 2; ++i) { const int pi = 2 * wid + i;
        { const int row = pi * 4 + (lane >> 4), lc = (lane & 15) ^ (row & 7); koff[i] = row * kvpitch + lc * 8; }
        { const int st = pi * 2 + (lane >> 5), kk = (st >> 2) * 8 + ((lane >> 2) & 7), c = (st & 3) * 32 + (lane & 3) * 8;
          const int k = (kk & ~0xC) | ((kk & 4) << 1) | ((kk & 8) >> 1); voff[i] = k * kvpitch + c; } }
#define A_DMA(t, bf) do { const size_t to_ = (size_t)(t) * 64 * kvpitch; ALAS unsigned char* d_ = lds + (bf) * BUFSZ + wid * 2048; \
        _Pragma("unroll") for (int s_ = 0; s_ < KSUB; ++s_) { dma16(Kp + to_ + s_ * 128 + koff[0], d_ + s_ * SUBT); dma16(Kp + to_ + s_ * 128 + koff[1], d_ + s_ * SUBT + 1024); } \
        _Pragma("unroll") for (int s_ = 0; s_ < VSUB; ++s_) { dma16(Vp + to_ + s_ * 128 + voff[0], d_ + (KSUB + s_) * SUBT); dma16(Vp + to_ + s_ * 128 + voff[1], d_ + (KSUB + s_) * SUBT + 1024); } } while (0)
    A_DMA(0, 0);
    bf16x8 qr[NKS];
    {
        const int qrow = qlo + r32; float ssq; const bf16_t* qp;
        const size_t tok = (size_t)b * SEQ + qrow;
        if constexpr (T == FOX)  { const f32x4 s4 = *(const f32x4*)(P.SS + tok * 96 + 48 + 4 * h); ssq = ((s4[0] + s4[1]) + (s4[2] + s4[3])) * (1.f / 128.f); qp = P.PROJ + tok * PROJW + 1536 + h * 128; }
        if constexpr (T == DIFF) { const float* sp = P.SS + tok * 96 + 4 * h + 2 * sel; ssq = (sp[0] + sp[1]) * (1.f / 64.f); qp = P.PROJ + tok * PROJW + h * 128 + sel * 64; }
        if constexpr (T == CROSS){ const f32x4 s4 = *(const f32x4*)(P.SSQC + tok * 32 + 8 * h), s5 = *(const f32x4*)(P.SSQC + tok * 32 + 8 * h + 4);
                                   ssq = (((s4[0] + s4[1]) + (s4[2] + s4[3])) + ((s5[0] + s5[1]) + (s5[2] + s5[3]))) * (1.f / 256.f); qp = P.QC + tok * DM + h * 256; }
        const float rq = __builtin_amdgcn_rsqf(ssq + NEPS);
#pragma unroll
        for (int ks = 0; ks < NKS; ++ks) { const u32x4 raw = *(const u32x4*)(qp + ks * 16 + hi * 8); qr[ks] = qprep(raw, rq, GQ + ks * 16 + hi * 8); }
    }
    float m_reg = -1e30f, l_reg = 0.f; f32x16 o[4];
#pragma unroll
    for (int d = 0; d < 4; ++d) o[d] = f32x16{};
    const int vbl = v_rd_base(lane);
    for (int t = 0; t < NT; ++t) {
        const int cur = t & 1, kb = t * 64;
        asm volatile("s_waitcnt vmcnt(0)" ::: "memory");
        __syncthreads();
        if (t + 1 < NT) A_DMA(t + 1, cur ^ 1);
        ALAS unsigned char* tb = lds + cur * BUFSZ;
        bool act;
        if constexpr (T == FOX)  act = (kb <= qlo + 31);
        if constexpr (T == DIFF) act = (t <= (qlo >> 6));
        if constexpr (T == CROSS) act = true;
        if (act) {
            f32x16 p0 = f32x16{}, p1 = f32x16{};
            {
                const ALAS unsigned char* kt = tb + ((T == DIFF) ? sel * 128 : 0);
#pragma unroll
                for (int ks = 0; ks < NKS; ++ks) {
                    const int sub = ks >> 3, dd = ks & 7;
                    const ALAS unsigned char* a = kt + sub * SUBT + kswz(r32, ((dd & 3) * 16 + hi * 8) * 2) + (dd >> 2) * 128;
                    const bf16x8 b0 = *(const ALAS bf16x8*)a, b1 = *(const ALAS bf16x8*)(a + 32 * 256);
                    p0 = __builtin_amdgcn_mfma_f32_32x32x16_bf16(b0, qr[ks], p0, 0, 0, 0);
                    p1 = __builtin_amdgcn_mfma_f32_32x32x16_bf16(b1, qr[ks], p1, 0, 0, 0);
                }
            }
            {
                const ALAS float* rkp = KT + ((T == DIFF) ? sel * 2048 : 0) + kb + 4 * hi;
                const bool near = (T == DIFF) ? (kb + 63 - qlo > -128) : false;
                const ALAS float* btp = BT + (kb - qlo + BT_OFF + 4 * hi - r32);
                const float bfar = (T == DIFF) ? BT[0] : 0.f;
#pragma unroll
                for (int g = 0; g < 4; ++g) {
                    const f32x4 rk0 = *(const ALAS f32x4*)(rkp + 8 * g), rk1 = *(const ALAS f32x4*)(rkp + 32 + 8 * g);
                    f32x4 a0 = {0.f, 0.f, 0.f, 0.f}, a1 = {0.f, 0.f, 0.f, 0.f};
                    if constexpr (T == FOX)  { a0 = *(const ALAS f32x4*)(rkp + 2048 + 8 * g); a1 = *(const ALAS f32x4*)(rkp + 2048 + 32 + 8 * g); }
                    if constexpr (T == DIFF) { if (near) { a0 = (f32x4){btp[8 * g], btp[8 * g + 1], btp[8 * g + 2], btp[8 * g + 3]}; a1 = (f32x4){btp[32 + 8 * g], btp[33 + 8 * g], btp[34 + 8 * g], btp[35 + 8 * g]}; }
                                               else { a0 = (f32x4){bfar, bfar, bfar, bfar}; a1 = a0; } }
#pragma unroll
                    for (int e = 0; e < 4; ++e) { p0[4 * g + e] = __builtin_fmaf(p0[4 * g + e], rk0[e], a0[e]); p1[4 * g + e] = __builtin_fmaf(p1[4 * g + e], rk1[e], a1[e]); }
                }
                if constexpr (T == FOX) {
                    if (kb + 63 > qlo) {
                        const float NEG = -__builtin_inff(); const int dq = qlo + r32 - kb - 4 * hi;
#pragma unroll
                        for (int r = 0; r < 16; ++r) { const int c = (r & 3) + 8 * (r >> 2); if (c > dq) p0[r] = NEG; if (c + 32 > dq) p1[r] = NEG; }
                    }
                }
            }
            float alpha;
            {
                float pmax = p0[0];
#pragma unroll
                for (int r = 1; r < 16; ++r) pmax = fmaxf(pmax, p0[r]);
#pragma unroll
                for (int r = 0; r < 16; ++r) pmax = fmaxf(pmax, p1[r]);
                { auto rr = __builtin_amdgcn_permlane32_swap(__float_as_uint(pmax), __float_as_uint(pmax), false, false); pmax = fmaxf(__uint_as_float(rr[0]), __uint_as_float(rr[1])); }
                if (__builtin_expect(__all(pmax - m_reg <= THR), 1)) { alpha = 1.f; }
                else { const float mn = fmaxf(m_reg, pmax); alpha = __builtin_amdgcn_exp2f(m_reg - mn); m_reg = mn; }
#pragma unroll
                for (int r = 0; r < 16; ++r) { p0[r] = __builtin_amdgcn_exp2f(p0[r] - m_reg); p1[r] = __builtin_amdgcn_exp2f(p1[r] - m_reg); }
                float ps = 0.f;
#pragma unroll
                for (int r = 0; r < 16; ++r) ps += p0[r] + p1[r];
                { auto rr = __builtin_amdgcn_permlane32_swap(__float_as_uint(ps), __float_as_uint(ps), false, false); ps = __uint_as_float(rr[0]) + __uint_as_float(rr[1]); }
                l_reg = l_reg * alpha + ps;
            }
            bf16x8 pa0, pa1, pa2, pa3;
#define A_PK4(Pv, B_, OUT) do { unsigned a0_ = cvtpk(Pv[B_ + 0], Pv[B_ + 1]), a1_ = cvtpk(Pv[B_ + 2], Pv[B_ + 3]), b0_ = cvtpk(Pv[B_ + 4], Pv[B_ + 5]), b1_ = cvtpk(Pv[B_ + 6], Pv[B_ + 7]); \
        auto r0_ = __builtin_amdgcn_permlane32_swap(a0_, b0_, false, false); auto r1_ = __builtin_amdgcn_permlane32_swap(a1_, b1_, false, false); \
        u32x4 w_ = {r0_[0], r1_[0], r0_[1], r1_[1]}; OUT = __builtin_bit_cast(bf16x8, w_); } while (0)
            A_PK4(p0, 0, pa0); A_PK4(p0, 8, pa1); A_PK4(p1, 0, pa2); A_PK4(p1, 8, pa3);
#undef A_PK4
            if (__any(alpha < 1.f)) {
                if (hi == 0) wsf[r32] = alpha;
                asm volatile("s_waitcnt lgkmcnt(0)" ::: "memory");
#pragma unroll
                for (int r = 0; r < 16; ++r) { const float al = wsf[crow(r, hi)];
#pragma unroll
                    for (int d = 0; d < 4; ++d) o[d][r] *= al; }
            }
            {
                const int vb0 = (int)(unsigned)(size_t)(tb + (KSUB + ((T == CROSS) ? sel : 0)) * SUBT) + vbl;
#define A_TRRD(dst, off) asm volatile("ds_read_b64_tr_b16 %0, %1 offset:%2" : "=&v"(dst) : "v"(vb0), "i"(off) : "memory")
#define A_PV(d0) do { s16x4 l0, l1, l2, l3, h0, h1, h2, h3; constexpr int b_ = (d0) * 512; \
        A_TRRD(l0, b_); A_TRRD(h0, b_ + 2048); A_TRRD(l1, b_ + 4096); A_TRRD(h1, b_ + 6144); A_TRRD(l2, b_ + 8192); A_TRRD(h2, b_ + 10240); A_TRRD(l3, b_ + 12288); A_TRRD(h3, b_ + 14336); \
        asm volatile("s_waitcnt lgkmcnt(0)" ::: "memory"); ASBAR(); \
        o[d0] = __builtin_amdgcn_mfma_f32_32x32x16_bf16(pa0, (bf16x8){l0[0], l0[1], l0[2], l0[3], h0[0], h0[1], h0[2], h0[3]}, o[d0], 0, 0, 0); \
        o[d0] = __builtin_amdgcn_mfma_f32_32x32x16_bf16(pa1, (bf16x8){l1[0], l1[1], l1[2], l1[3], h1[0], h1[1], h1[2], h1[3]}, o[d0], 0, 0, 0); \
        o[d0] = __builtin_amdgcn_mfma_f32_32x32x16_bf16(pa2, (bf16x8){l2[0], l2[1], l2[2], l2[3], h2[0], h2[1], h2[2], h2[3]}, o[d0], 0, 0, 0); \
        o[d0] = __builtin_amdgcn_mfma_f32_32x32x16_bf16(pa3, (bf16x8){l3[0], l3[1], l3[2], l3[3], h3[0], h3[1], h3[2], h3[3]}, o[d0], 0, 0, 0); } while (0)
                A_PV(0); A_PV(1); A_PV(2); A_PV(3);
#undef A_PV
#undef A_TRRD
            }
        }
    }
#undef A_DMA
    __syncthreads();
    if (hi == 0) wsf[32 + r32] = l_reg;
    asm volatile("s_waitcnt lgkmcnt(0)" ::: "memory");
#pragma unroll
    for (int r = 0; r < 16; ++r) { const float rl = __builtin_amdgcn_rcpf(wsf[32 + crow(r, hi)]);
#pragma unroll
        for (int d = 0; d < 4; ++d) o[d][r] *= rl; }
    if constexpr (T == DIFF) {
        ALAS float* hnd = (ALAS float*)lds + (size_t)rg * 4096 + lane;
        if (sel == 1) {
#pragma unroll
            for (int d = 0; d < 4; ++d)
#pragma unroll
                for (int r = 0; r < 16; ++r) hnd[(d * 16 + r) * 64] = o[d][r];
        }
        __syncthreads();
        if (sel == 0) {
#pragma unroll
            for (int d = 0; d < 4; ++d)
#pragma unroll
                for (int r = 0; r < 16; ++r) o[d][r] = o[d][r] - P.lam * hnd[(d * 16 + r) * 64];
        }
    }
    if (T == CROSS || sel == 0) {
        float gcol[4]; bf16_t* op;
        if constexpr (T == FOX)  { op = P.MIX + ((size_t)b * SEQ + qlo) * DM + 512 + h * 128;
#pragma unroll
            for (int d = 0; d < 4; ++d) gcol[d] = P.g_fox_out[32 * d + r32]; }
        if constexpr (T == DIFF) { op = P.MIX + ((size_t)b * SEQ + qlo) * DM + h * 128;
#pragma unroll
            for (int d = 0; d < 4; ++d) gcol[d] = P.g_subln[32 * d + r32] * P.one_m_lam_init; }
        if constexpr (T == CROSS){ op = P.CO + ((size_t)b * SEQ + qlo) * DM + h * 256 + sel * 128;
#pragma unroll
            for (int d = 0; d < 4; ++d) gcol[d] = 1.f; }
        ALAS bf16_t* stg = (ALAS bf16_t*)(lds + STG_OFF) + ((T == DIFF) ? rg : wid) * 4096;
#pragma unroll
        for (int r = 0; r < 16; ++r) {
            float rs = 1.f;
            if constexpr (T != CROSS) {
                float s = (o[0][r] * o[0][r] + o[1][r] * o[1][r]) + (o[2][r] * o[2][r] + o[3][r] * o[3][r]);
                s += __shfl_xor(s, 1); s += __shfl_xor(s, 2); s += __shfl_xor(s, 4); s += __shfl_xor(s, 8); s += __shfl_xor(s, 16);
                rs = __builtin_amdgcn_rsqf(s * (1.f / 128.f) + NEPS);
            }
            const int orow = crow(r, hi);
#pragma unroll
            for (int d = 0; d < 4; ++d) { const unsigned w = cvtpk(o[d][r] * rs * gcol[d], 0.f); stg[orow * 128 + 32 * d + r32] = (bf16_t)(w & 0xffffu); }
        }
        asm volatile("s_waitcnt lgkmcnt(0)" ::: "memory");
#pragma unroll
        for (int i = 0; i < 8; ++i) { const int row = i * 4 + (lane >> 4), ch = lane & 15; const u32x4 v = *(const ALAS u32x4*)(stg + row * 128 + ch * 8); *(u32x4*)(op + (size_t)row * DM + ch * 8) = v; }
    }
    __syncthreads();
}
#undef ASBAR
}
constexpr int NWAVES = 8, NTHR = NWAVES * 64;
constexpr int BATCH = 8, SEQ = 2048, DM = 1024, NTOK = BATCH * SEQ, NMEM = 256, MROWS = BATCH * NMEM;
constexpr int INCOLS = 3076, PROJW = 3072, NEXP = 16, DEXP = 512;
constexpr int SLOT_MAX = 2 * NTOK + NEXP * 256;
constexpr float EPS = 1e-6f, LOG2E = 1.4426950408889634f;
#ifndef MK_ONE_LAUNCH
#define MK_ONE_LAUNCH 1
#endif
#ifndef MK_PH_END
#define MK_PH_END 12
#endif
constexpr int N_PHASES = 12;
constexpr size_t MiB = 1u << 20, KiB = 1u << 10;
constexpr size_t WS_CTL = 0, CTL_ZERO_BYTES = 1 * MiB;
constexpr size_t WS_WIN = 2 * MiB, WS_WOUT = 8 * MiB, WS_WCQ = 10 * MiB, WS_WCKV = 12 * MiB, WS_WCO = 16 * MiB, WS_W1 = 18 * MiB, WS_W2 = 50 * MiB;
constexpr size_t WS_MEMN = 66 * MiB, WS_KVC = 70 * MiB, WS_SS = 78 * MiB, WS_H = 84 * MiB, WS_PROJ = 116 * MiB, WS_ACT = 212 * MiB, WS_SM = 248 * MiB, WS_END = 256 * MiB;
constexpr size_t WS_QC = WS_PROJ, WS_CO = WS_PROJ + 32 * MiB, WS_TPERM = WS_PROJ;
constexpr size_t WS_NEGC = WS_SM, WS_LOGF = WS_SM + 256 * KiB, WS_CHOICE = WS_SM + 512 * KiB, WS_SLOTTOK = WS_SM + 768 * KiB, WS_SLOTW = WS_SM + 928 * KiB,
                 WS_CHUNKCNT = WS_SM + 1088 * KiB, WS_MOESEG = WS_SM + 1104 * KiB, WS_SSKV = WS_SM + 2 * MiB, WS_SSQC = WS_SM + 3 * MiB;
static_assert(WS_TPERM + (size_t)SLOT_MAX * DM * 2 <= WS_ACT && WS_ACT + (size_t)SLOT_MAX * DEXP * 2 <= WS_SM && WS_SSQC + (size_t)NTOK * 32 * 4 <= WS_END, "d_ws map");
constexpr int CW_TMO = 0, CW_QFOX = 64, CW_QDIFF = 128, CW_BAR = 4096;
constexpr int RING_BYTES = 133120;
constexpr int L_WSF = RING_BYTES, L_GQ = L_WSF + 2048, L_BT = L_GQ + 1024, L_MISC = L_BT + 4 * att::BT_N * 4, L_TILEE = L_MISC + 256, LDS_BYTES = 147456;
static_assert(RING_BYTES >= pg8::STAGE_BYTES && L_TILEE + 160 * 4 <= LDS_BYTES, "LDS map");

#define GAS __attribute__((address_space(1)))
#define LAS __attribute__((address_space(3)))
typedef unsigned short bf16;
typedef unsigned v4u __attribute__((ext_vector_type(4)));
typedef float f32x4 __attribute__((ext_vector_type(4)));
typedef short bf16x8 __attribute__((ext_vector_type(8)));
typedef GAS unsigned gu32;
typedef GAS unsigned long long gu64;
#define RLX_AGENT __ATOMIC_RELAXED, __HIP_MEMORY_SCOPE_AGENT
#define LDS_WAIT() asm volatile("s_waitcnt lgkmcnt(0)" ::: "memory")
#define VM_WAIT() asm volatile("s_waitcnt vmcnt(0)" ::: "memory")
__device__ __forceinline__ unsigned long long rt() { return __builtin_amdgcn_s_memrealtime(); }
__device__ __forceinline__ unsigned f2bf(float f) { unsigned u = __builtin_bit_cast(unsigned, f); return (u + 0x7fffu + ((u >> 16) & 1u)) >> 16; }
__device__ __forceinline__ unsigned pk2(float lo, float hi) { return f2bf(lo) | (f2bf(hi) << 16); }
#define XB_TMO      128
#define XB_XCNT(j)  (256  + 64 * (j))
#define XB_XSUB(j)  (1280 + 64 * (j))
#define XB_XGEN(j)  (2304 + 64 * (j))
#define XB_TOP      3328
#define XB_TOPGEN   3392
#define XCD_BAR_WORDS 3456
#define XB_SPIN_CAP (1u << 18)

__device__ __forceinline__ unsigned xb_ld(unsigned* p)              { return __hip_atomic_load(p, __ATOMIC_RELAXED, __HIP_MEMORY_SCOPE_AGENT); }
__device__ __forceinline__ unsigned xb_add(unsigned* p, unsigned v) { return __hip_atomic_fetch_add(p, v, __ATOMIC_RELAXED, __HIP_MEMORY_SCOPE_AGENT); }
__device__ __forceinline__ unsigned xb_xcc_id() { return (unsigned)__builtin_amdgcn_s_getreg((3 << 11) | 20) & 0xFu; }
#define XB_SPIN(cond, bar) do { unsigned _sp = 0; while (cond) { __builtin_amdgcn_s_sleep(1); \
    if ((++_sp & 255u) == 0u) { if (xb_ld(&(bar)[XB_TMO])) break; if (_sp > XB_SPIN_CAP) { atomicAdd(&(bar)[XB_TMO], 1u); break; } } } } while (0)

struct XcdBarrier {
    unsigned* bar; unsigned x;
    volatile LAS unsigned* st;
};

__device__ __forceinline__ XcdBarrier xcd_barrier_post(unsigned* bar, volatile LAS unsigned* st) {
    XcdBarrier b; b.bar = bar; b.x = xb_xcc_id(); b.st = st;
    if (threadIdx.x == 0) (void)xb_add(&bar[XB_XCNT(b.x)], 1u);
    return b;
}
__device__ __forceinline__ void xcd_barrier_complete(unsigned* bar, unsigned x, unsigned& nloc, unsigned& nx) {
    const unsigned G = gridDim.x * gridDim.y * gridDim.z;
    unsigned sum, cnt, mine, sp = 0u;
    for (;;) {
        sum = 0u; cnt = 0u; mine = 0u;
#pragma unroll
        for (unsigned j = 0; j < 16; ++j) { const unsigned c = xb_ld(&bar[XB_XCNT(j)]); sum += c; cnt += (c > 0u) ? 1u : 0u; mine = (j == x) ? c : mine; }
        if (sum == G) break;
        __builtin_amdgcn_s_sleep(1);
        if ((++sp & 255u) == 0u) { if (xb_ld(&bar[XB_TMO])) break; if (sp > XB_SPIN_CAP) { atomicAdd(&bar[XB_TMO], 1u); break; } }
    }
    nloc = mine > 0u ? mine : 1u; nx = cnt > 0u ? cnt : 1u;
}

__device__ __forceinline__ void xcd_barrier(const XcdBarrier& b) {
    asm volatile("s_waitcnt vmcnt(0)" ::: "memory");
    __syncthreads();
    if (threadIdx.x == 0) {
        unsigned* bar = b.bar;
        __builtin_amdgcn_s_waitcnt(0);
        unsigned nloc = b.st[0], nx = b.st[1];
        if (nloc == 0u) { xcd_barrier_complete(bar, b.x, nloc, nx); b.st[0] = nloc; b.st[1] = nx; }
        const unsigned old = xb_add(&bar[XB_XSUB(b.x)], 1u);
        const unsigned gen = old / nloc;
        if (old + 1u == (gen + 1u) * nloc) {
            __builtin_amdgcn_fence(__ATOMIC_RELEASE, "agent");
            asm volatile("s_waitcnt vmcnt(0)" ::: "memory");
            const unsigned og = xb_add(&bar[XB_TOP], 1u);
            const unsigned tg = og / nx;
            if (og + 1u == (tg + 1u) * nx) xb_add(&bar[XB_TOPGEN], 1u);
            else XB_SPIN(xb_ld(&bar[XB_TOPGEN]) == tg, bar);
            __builtin_amdgcn_fence(__ATOMIC_ACQUIRE, "agent");
            xb_add(&bar[XB_XGEN(b.x)], 1u);
            asm volatile("s_waitcnt vmcnt(0)" ::: "memory");
        } else {
            XB_SPIN(xb_ld(&bar[XB_XGEN(b.x)]) == gen, bar);
            __builtin_amdgcn_fence(__ATOMIC_ACQUIRE, "agent");
            asm volatile("s_waitcnt vmcnt(0)" ::: "memory");
        }
    }
    __syncthreads();
}

__device__ __forceinline__ float wave_sum(float v) {
#pragma unroll
    for (int o = 1; o < 64; o <<= 1) v += __shfl_xor(v, o);
    return v;
}
__device__ __forceinline__ void tr_item(const float* W, int ldw, int k0, int n0, bf16* WT, int drow0, int K, LAS float* scr, int lane) {
#pragma unroll 8
    for (int i = 0; i < 32; ++i) { const int kk = 2 * i + (lane >> 5); scr[kk * 33 + (lane & 31)] = W[(size_t)(k0 + kk) * ldw + n0 + (lane & 31)]; }
    LDS_WAIT(); asm volatile("" ::: "memory");
    const int c = lane & 7;
#pragma unroll
    for (int j = 0; j < 4; ++j) { const int n = (lane >> 3) + 8 * j; const LAS float* s = scr + (8 * c) * 33 + n;
        v4u o; o.x = pk2(s[0 * 33], s[1 * 33]); o.y = pk2(s[2 * 33], s[3 * 33]); o.z = pk2(s[4 * 33], s[5 * 33]); o.w = pk2(s[6 * 33], s[7 * 33]);
        *(GAS v4u*)(WT + (size_t)(drow0 + n) * K + k0 + 8 * c) = o; }
    LDS_WAIT(); asm volatile("" ::: "memory");
}
__device__ __forceinline__ float row_load_rstd(const float* xrow, int lane, f32x4 (&v)[4]) {
    const GAS f32x4* xr = (const GAS f32x4*)xrow + lane; float s = 0.f;
#pragma unroll
    for (int j = 0; j < 4; ++j) { v[j] = xr[64 * j]; s += (v[j].x * v[j].x + v[j].y * v[j].y) + (v[j].z * v[j].z + v[j].w * v[j].w); }
    return 1.0f / sqrtf(wave_sum(s) * (1.f / DM) + EPS);
}
__device__ __forceinline__ void row_store_bf16(bf16* orow, int lane, const f32x4 (&v)[4]) {
    GAS unsigned long long* o8 = (GAS unsigned long long*)orow + lane;
#pragma unroll
    for (int j = 0; j < 4; ++j) o8[64 * j] = (unsigned long long)pk2(v[j].x, v[j].y) | ((unsigned long long)pk2(v[j].z, v[j].w) << 32);
}
__device__ __forceinline__ int t5_bucket(int rel) {
    const int ret = rel > 0 ? 16 : 0, n = rel < 0 ? -rel : rel;
    int v;
    if (n < 8) v = n; else if (n < 12) v = 8; else if (n < 16) v = 9; else if (n < 23) v = 10; else if (n < 32) v = 11; else if (n < 46) v = 12; else if (n < 64) v = 13; else if (n < 91) v = 14; else v = 15;
    return ret + v;
}

struct Args { const float* in[32]; float* out; unsigned char* ws; int ph_lo, ph_hi; };
__global__ void __launch_bounds__(NTHR, 2) mk_fwd(Args args) {
    extern __shared__ __attribute__((aligned(16))) unsigned char lds_raw[];
    LAS unsigned char* lds = (LAS unsigned char*)lds_raw;
    volatile LAS unsigned* MISC = (volatile LAS unsigned*)(lds + L_MISC);
    const int tid = threadIdx.x, lane = tid & 63, wave = __builtin_amdgcn_readfirstlane(tid >> 6);
    const int G = gridDim.x, bx = blockIdx.x;
    unsigned char* ws = args.ws;
    gu32* ctl = (gu32*)(ws + WS_CTL);
    float* out = args.out;
    bf16* W_IN = (bf16*)(ws + WS_WIN); bf16* W_OUT = (bf16*)(ws + WS_WOUT); bf16* W_CQ = (bf16*)(ws + WS_WCQ); bf16* W_CKV = (bf16*)(ws + WS_WCKV); bf16* W_CO = (bf16*)(ws + WS_WCO);
    bf16* W1 = (bf16*)(ws + WS_W1); bf16* W2 = (bf16*)(ws + WS_W2);
    bf16* MEMN = (bf16*)(ws + WS_MEMN); bf16* KVC = (bf16*)(ws + WS_KVC); float* SS = (float*)(ws + WS_SS); bf16* H = (bf16*)(ws + WS_H); bf16* PROJ = (bf16*)(ws + WS_PROJ);
    bf16* ACT = (bf16*)(ws + WS_ACT); bf16* QC = (bf16*)(ws + WS_QC); bf16* CO = (bf16*)(ws + WS_CO); bf16* TPERM = (bf16*)(ws + WS_TPERM);
    float* NEGC = (float*)(ws + WS_NEGC); float* LOGF = (float*)(ws + WS_LOGF); float* SSKV = (float*)(ws + WS_SSKV); float* SSQC = (float*)(ws + WS_SSQC);
    int* CHOICE = (int*)(ws + WS_CHOICE); int* SLOTTOK = (int*)(ws + WS_SLOTTOK); float* SLOTW = (float*)(ws + WS_SLOTW); int* CHUNKCNT = (int*)(ws + WS_CHUNKCNT); int* MOESEG = (int*)(ws + WS_MOESEG);

    for (int u = tid; u < (LDS_BYTES - L_MISC) / 4; u += NTHR) ((LAS unsigned*)(lds + L_MISC))[u] = 0u;
    __syncthreads();
    XcdBarrier bar; bar.bar = (unsigned*)(ctl + CW_BAR); bar.x = 0; bar.st = nullptr;
    if (MK_ONE_LAUNCH) bar = xcd_barrier_post((unsigned*)(ctl + CW_BAR), MISC + 8);
    const int lo = args.ph_lo, hi = args.ph_hi;
#ifndef MK_PHMASK
#define MK_PHMASK 0xFFF
#endif
#define IN(k) (((MK_PHMASK >> (k)) & 1) && lo <= (k) && (k) < hi)
#define SEAM(k) do { if (MK_ONE_LAUNCH && IN((k) + 1)) xcd_barrier(bar); } while (0)

    if (IN(0)) {
        const int gw = bx * NWAVES + wave, NGW = G * NWAVES;
        LAS float* scr = (LAS float*)(lds + wave * 8704);
        LAS float* wf = (LAS float*)(lds + 73728);
        const float* w_in = args.in[4];
        for (int i = tid; i < 4096; i += NTHR) { const int k = i >> 2, j = i & 3; wf[j * 1024 + k] = w_in[(size_t)k * INCOLS + PROJW + j]; }
        constexpr int I_IN = 16 * 96, I_SQ = 16 * 32, I_CKV = 16 * 64, I_E = 16 * 256;
        constexpr int NITEMS = I_IN + 3 * I_SQ + I_CKV + 3 * I_E;
        for (int it = gw; it < NITEMS; it += NGW) {
            int r = it;
            if (r < I_IN) { tr_item(w_in, INCOLS, 64 * (r / 96), 32 * (r % 96), W_IN, 32 * (r % 96), DM, scr, lane); continue; } r -= I_IN;
            if (r < I_SQ) { tr_item(args.in[16], DM, 64 * (r / 32), 32 * (r % 32), W_OUT, 32 * (r % 32), DM, scr, lane); continue; } r -= I_SQ;
            if (r < I_SQ) { tr_item(args.in[19], DM, 64 * (r / 32), 32 * (r % 32), W_CQ, 32 * (r % 32), DM, scr, lane); continue; } r -= I_SQ;
            if (r < I_SQ) { tr_item(args.in[23], DM, 64 * (r / 32), 32 * (r % 32), W_CO, 32 * (r % 32), DM, scr, lane); continue; } r -= I_SQ;
            if (r < I_CKV) { tr_item(args.in[20], 2 * DM, 64 * (r / 64), 32 * (r % 64), W_CKV, 32 * (r % 64), DM, scr, lane); continue; } r -= I_CKV;
            if (r < 2 * I_E) {
                const int up = r >= I_E ? 1 : 0; r -= up * I_E; const int e = r >> 8, q = r & 255, kb = q >> 4, nb = q & 15, c0 = 32 * nb;
                const float* src = (up ? args.in[30] : args.in[29]) + (size_t)e * DM * DEXP;
                tr_item(src, DEXP, 64 * kb, c0, W1, e * 1024 + (c0 >> 7) * 256 + up * 128 + (c0 & 127), DM, scr, lane); continue; } r -= 2 * I_E;
            { const int e = r >> 8, q = r & 255, kb = q >> 5, nb = q & 31;
              tr_item(args.in[31] + (size_t)e * DEXP * DM, DM, 64 * kb, 32 * nb, W2, e * 1024 + 32 * nb, DEXP, scr, lane); }
        }
        __syncthreads();
        {
            const float* x = args.in[0]; const float* g = args.in[3]; const float* bfg = args.in[5];
            f32x4 gv[4];
#pragma unroll
            for (int j = 0; j < 4; ++j) gv[j] = *((const GAS f32x4*)g + lane + 64 * j);
            for (int m = gw; m < NTOK; m += NGW) {
                f32x4 v[4]; const float rstd = row_load_rstd(x + (size_t)m * DM, lane, v);
                float d0 = 0.f, d1 = 0.f, d2 = 0.f, d3 = 0.f;
#pragma unroll
                for (int j = 0; j < 4; ++j) { v[j] = v[j] * rstd * gv[j];
                    const f32x4 w0 = *(const LAS f32x4*)(wf + 4 * lane + 256 * j), w1 = *(const LAS f32x4*)(wf + 1024 + 4 * lane + 256 * j), w2 = *(const LAS f32x4*)(wf + 2048 + 4 * lane + 256 * j), w3 = *(const LAS f32x4*)(wf + 3072 + 4 * lane + 256 * j);
                    d0 += (v[j].x * w0.x + v[j].y * w0.y) + (v[j].z * w0.z + v[j].w * w0.w); d1 += (v[j].x * w1.x + v[j].y * w1.y) + (v[j].z * w1.z + v[j].w * w1.w);
                    d2 += (v[j].x * w2.x + v[j].y * w2.y) + (v[j].z * w2.z + v[j].w * w2.w); d3 += (v[j].x * w3.x + v[j].y * w3.y) + (v[j].z * w3.z + v[j].w * w3.w); }
                row_store_bf16(H + (size_t)m * DM, lane, v);
                d0 = wave_sum(d0); d1 = wave_sum(d1); d2 = wave_sum(d2); d3 = wave_sum(d3);
                if (lane < 4) { const float z = (lane == 0 ? d0 : lane == 1 ? d1 : lane == 2 ? d2 : d3) + bfg[lane];
                    const float ls = fminf(z, 0.f) - log1pf(expf(-fabsf(z)));
                    LOGF[(size_t)((m >> 11) * 4 + lane) * SEQ + (m & (SEQ - 1))] = ls; }
            }
        }
        {
            const float* mem = args.in[1]; const float* g = args.in[18];
            f32x4 gv[4];
#pragma unroll
            for (int j = 0; j < 4; ++j) gv[j] = *((const GAS f32x4*)g + lane + 64 * j);
            for (int m = gw; m < MROWS; m += NGW) { f32x4 v[4]; const float rstd = row_load_rstd(mem + (size_t)m * DM, lane, v);
#pragma unroll
                for (int j = 0; j < 4; ++j) v[j] = v[j] * rstd * gv[j];
                row_store_bf16(MEMN + (size_t)m * DM, lane, v); }
        }
        SEAM(0);
    }

    if (IN(1)) {
        for (int bh = bx; bh < BATCH * 4; bh += G) {
            LAS float* wt = (LAS float*)lds;
            const f32x4 v = *(const f32x4*)(LOGF + (size_t)bh * SEQ + 4 * tid);
            const float c0 = v.x, c1 = c0 + v.y, c2 = c1 + v.z, c3 = c2 + v.w;
            float s = c3;
#pragma unroll
            for (int o = 1; o < 64; o <<= 1) { const float n = __shfl_up(s, o); if (lane >= o) s += n; }
            if (lane == 63) wt[wave] = s;
            __syncthreads();
            float base = s - c3;
            for (int w = 0; w < wave; ++w) base += wt[w];
            *(f32x4*)(NEGC + (size_t)bh * SEQ + 4 * tid) = (f32x4){-(base + c0) * LOG2E, -(base + c1) * LOG2E, -(base + c2) * LOG2E, -(base + c3) * LOG2E};
            __syncthreads();
        }
        { pg8::Gemm g{H, W_IN, NTOK, PROJW, DM}; pg8::StaticOrder S; S.init(NTOK, PROJW, G, bx);
          pg8::EpiBf16SS E{PROJ, PROJW, SS, 96, 0x3CFu};
          pg8::gemm_phase<pg8::EpiBf16SS, pg8::StaticOrder, true, true>(lds, g, S, E); }
        { pg8::Gemm g{MEMN, W_CKV, MROWS, 2 * DM, DM}; pg8::StaticOrder S; S.init(MROWS, 2 * DM, G, bx);
          pg8::EpiBf16SS E{KVC, 2 * DM, SSKV, 64, 0x0Fu};
          pg8::gemm_phase<pg8::EpiBf16SS, pg8::StaticOrder, true, true>(lds, g, S, E); }
        SEAM(1);
    }

    if (IN(2)) {
        att::Ptrs P; P.PROJ = PROJ; P.SS = SS; P.NEGC = NEGC; P.QC = QC; P.SSQC = SSQC; P.KVC = KVC; P.SSKV = SSKV; P.MIX = H; P.CO = CO;
        P.g_fox_out = args.in[15]; P.g_subln = args.in[12];
        { float a = args.in[8][lane] * args.in[9][lane], c = args.in[10][lane] * args.in[11][lane]; a = wave_sum(a); c = wave_sum(c);
          const float lam_init = 0.8f - 0.6f; P.lam = expf(a) - expf(c) + lam_init; P.one_m_lam_init = 1.0f - lam_init; }
        LAS float* wsf = (LAS float*)(lds + L_WSF) + wave * 64; LAS float* GQ = (LAS float*)(lds + L_GQ); LAS float* BT = (LAS float*)(lds + L_BT);
        if (tid < 128) GQ[tid] = args.in[13][tid] * args.in[14][tid] * (0.08838834764831845f * LOG2E);
        __syncthreads();
        for (;;) {
            if (tid == 0) MISC[0] = __hip_atomic_fetch_add(ctl + CW_QFOX, 1u, RLX_AGENT);
            __syncthreads();
            const int it = (int)MISC[0];
            __syncthreads();
            if (it >= 256) break;
            const int blk = 7 - (it >> 5), bh = it & 31;
#ifndef MK_NO_FOX
            att::attn_unit<att::FOX>(P, bh >> 2, bh & 3, blk, lds, wsf, GQ, BT);
#endif
        }
        __syncthreads();
        if (tid < 64) GQ[tid] = args.in[6][tid] * args.in[7][tid] * (0.125f * LOG2E);
        for (int i = tid; i < 4 * att::BT_N; i += NTHR) { const int hh = i / att::BT_N, rel = i % att::BT_N - att::BT_OFF; BT[i] = args.in[2][t5_bucket(rel) * 4 + hh] * LOG2E; }
        __syncthreads();
        for (;;) {
            if (tid == 0) MISC[0] = __hip_atomic_fetch_add(ctl + CW_QDIFF, 1u, RLX_AGENT);
            __syncthreads();
            const int it = (int)MISC[0];
            __syncthreads();
            if (it >= 512) break;
            const int blk = 15 - (it >> 5), bh = it & 31;
#ifndef MK_NO_DIFF
            att::attn_unit<att::DIFF>(P, bh >> 2, bh & 3, blk, lds, wsf, GQ, BT + (bh & 3) * att::BT_N);
#endif
        }
        SEAM(2);
    }

    if (IN(3)) {
        pg8::Gemm g{H, W_OUT, NTOK, DM, DM}; pg8::StaticOrder S; S.init(NTOK, DM, G, bx);
        pg8::EpiResF32 E{args.in[0], out, DM};
        pg8::gemm_phase<pg8::EpiResF32, pg8::StaticOrder, true, true>(lds, g, S, E);
        SEAM(3);
    }

    if (IN(4)) {
        const int gw = bx * NWAVES + wave, NGW = G * NWAVES; const float* g = args.in[17];
        f32x4 gv[4];
#pragma unroll
        for (int j = 0; j < 4; ++j) gv[j] = *((const GAS f32x4*)g + lane + 64 * j);
        for (int m = gw; m < NTOK; m += NGW) { f32x4 v[4]; const float rstd = row_load_rstd(out + (size_t)m * DM, lane, v);
#pragma unroll
            for (int j = 0; j < 4; ++j) v[j] = v[j] * rstd * gv[j];
            row_store_bf16(H + (size_t)m * DM, lane, v); }
        SEAM(4);
    }

    if (IN(5)) {
        pg8::Gemm g{H, W_CQ, NTOK, DM, DM}; pg8::StaticOrder S; S.init(NTOK, DM, G, bx);
        pg8::EpiBf16SS E{QC, DM, SSQC, 32, 0xFu};
        pg8::gemm_phase<pg8::EpiBf16SS, pg8::StaticOrder, true, true>(lds, g, S, E);
        SEAM(5);
    }

    if (IN(6)) {
        att::Ptrs P; P.PROJ = PROJ; P.SS = SS; P.NEGC = NEGC; P.QC = QC; P.SSQC = SSQC; P.KVC = KVC; P.SSKV = SSKV; P.MIX = H; P.CO = CO;
        P.g_fox_out = args.in[15]; P.g_subln = args.in[12]; P.lam = 0.f; P.one_m_lam_init = 1.f;
        LAS float* wsf = (LAS float*)(lds + L_WSF) + wave * 64; LAS float* GQ = (LAS float*)(lds + L_GQ); LAS float* BT = (LAS float*)(lds + L_BT);
        if (tid < 256) GQ[tid] = args.in[21][tid] * args.in[22][tid] * (0.0625f * LOG2E);
        __syncthreads();
        for (int it = bx; it < 512; it += G) { const int bh = it >> 4, blk = it & 15; att::attn_unit<att::CROSS>(P, bh >> 2, bh & 3, blk, lds, wsf, GQ, BT); }
        SEAM(6);
    }

    if (IN(7)) {
        pg8::Gemm g{CO, W_CO, NTOK, DM, DM}; pg8::StaticOrder S; S.init(NTOK, DM, G, bx);
        pg8::EpiResF32 E{out, out, DM};
        pg8::gemm_phase<pg8::EpiResF32, pg8::StaticOrder, true, true>(lds, g, S, E);
        SEAM(7);
    }

    if (IN(8)) {
        LAS float* WR = (LAS float*)lds;
        LAS int* cntL = (LAS int*)(lds + 20 * 1024 * 4);
        for (int i = tid; i < 4096; i += NTHR) WR[(i & 3) * 1024 + (i >> 2)] = args.in[25][i];
        for (int i = tid; i < 16384; i += NTHR) WR[(4 + (i & 15)) * 1024 + (i >> 4)] = args.in[27][i];
        const float* g = args.in[24]; const float* bgr = args.in[26]; const float* ber = args.in[28];
        f32x4 gv[4];
#pragma unroll
        for (int j = 0; j < 4; ++j) gv[j] = *((const GAS f32x4*)g + lane + 64 * j);
        for (int c = bx; c < NTOK / 64; c += G) {
            if (tid < 16) cntL[tid] = 0;
            __syncthreads();
            for (int i = 0; i < 8; ++i) {
                const int m = c * 64 + wave * 8 + i;
                f32x4 v[4]; const float rstd = row_load_rstd(out + (size_t)m * DM, lane, v);
#pragma unroll
                for (int j = 0; j < 4; ++j) v[j] = v[j] * rstd * gv[j];
                row_store_bf16(H + (size_t)m * DM, lane, v);
                float lg[20];
#pragma unroll
                for (int q = 0; q < 20; ++q) { float a = 0.f;
#pragma unroll
                    for (int j = 0; j < 4; ++j) { const f32x4 w = *(const LAS f32x4*)(WR + q * 1024 + 4 * lane + 256 * j); a += (v[j].x * w.x + v[j].y * w.y) + (v[j].z * w.z + v[j].w * w.w); }
                    lg[q] = wave_sum(a); }
                float gl[4]; int gi = 0;
#pragma unroll
                for (int q = 0; q < 4; ++q) gl[q] = lg[q] + bgr[q];
                float gm = gl[0];
#pragma unroll
                for (int q = 1; q < 4; ++q) if (gl[q] > gm) { gm = gl[q]; gi = q; }
                float gs = 0.f;
#pragma unroll
                for (int q = 0; q < 4; ++q) gs += expf(gl[q] - gm);
                const float pg = 1.0f / gs;
                float el[4];
#pragma unroll
                for (int q = 0; q < 4; ++q) { float sv = lg[4 + q] + ber[q];
#pragma unroll
                    for (int gg = 1; gg < 4; ++gg) sv = (gi == gg) ? lg[4 + 4 * gg + q] + ber[4 * gg + q] : sv;
                    el[q] = sv; }
                int i0 = 0; float m0 = el[0];
#pragma unroll
                for (int q = 1; q < 4; ++q) if (el[q] > m0) { m0 = el[q]; i0 = q; }
                int i1 = -1; float m1 = -__builtin_inff();
#pragma unroll
                for (int q = 0; q < 4; ++q) if (q != i0 && el[q] > m1) { m1 = el[q]; i1 = q; }
                const float e1 = expf(m1 - m0), w0 = pg / (1.0f + e1), w1 = pg * e1 / (1.0f + e1);
                if (lane == 0) { const int ea = gi * 4 + i0, eb = gi * 4 + i1; *(int4*)(CHOICE + (size_t)m * 4) = make_int4(ea, eb, __float_as_int(w0), __float_as_int(w1));
                    __hip_atomic_fetch_add(cntL + ea, 1, __ATOMIC_RELAXED, __HIP_MEMORY_SCOPE_WORKGROUP); __hip_atomic_fetch_add(cntL + eb, 1, __ATOMIC_RELAXED, __HIP_MEMORY_SCOPE_WORKGROUP); }
            }
            __syncthreads();
            if (tid < 16) CHUNKCNT[c * 16 + tid] = cntL[tid];
            __syncthreads();
        }
        SEAM(8);
    }

    if (IN(9)) {
        LAS int* cc = (LAS int*)lds;
        LAS int* tot = cc + 4096; LAS int* pre = tot + 16; LAS int* segs = pre + 16; LAS int* chL = segs + 16; LAS int* slotL = chL + 256;
        for (int i = tid; i < 4096; i += NTHR) cc[i] = CHUNKCNT[i];
        __syncthreads();
        if (tid < 16) { int s = 0; for (int c = 0; c < 256; ++c) s += cc[c * 16 + tid]; tot[tid] = s; }
        __syncthreads();
        if (tid < 16) { int st = 0; for (int e = 0; e < tid; ++e) st += (tot[e] + 255) & ~255; segs[tid] = st; }
        __syncthreads();
        if (bx == 0 && tid < 16) { MOESEG[2 * tid] = segs[tid]; MOESEG[2 * tid + 1] = tot[tid]; }
        for (int c = bx; c < NTOK / 64; c += G) {
            if (tid < 16) { int s = 0; for (int c2 = 0; c2 < c; ++c2) s += cc[c2 * 16 + tid]; pre[tid] = segs[tid] + s; }
            if (tid < 256) chL[tid] = CHOICE[(size_t)c * 256 + tid];
            __syncthreads();
            if (tid < 16) { int pos = pre[tid];
                for (int i = 0; i < 64; ++i) { if (chL[i * 4] == tid) slotL[i * 2] = pos++; if (chL[i * 4 + 1] == tid) slotL[i * 2 + 1] = pos++; } }
            __syncthreads();
            for (int i = 0; i < 8; ++i) { const int tl = wave * 8 + i, m = c * 64 + tl;
                const v4u a = *((const GAS v4u*)(H + (size_t)m * DM) + lane), b = *((const GAS v4u*)(H + (size_t)m * DM) + 64 + lane);
#pragma unroll
                for (int k = 0; k < 2; ++k) { const int slot = slotL[tl * 2 + k];
                    *((GAS v4u*)(TPERM + (size_t)slot * DM) + lane) = a; *((GAS v4u*)(TPERM + (size_t)slot * DM) + 64 + lane) = b;
                    if (lane == 0) { SLOTTOK[slot] = m; SLOTW[slot] = __int_as_float(chL[tl * 4 + 2 + k]); } } }
            __syncthreads();
        }
        SEAM(9);
    }

    if (IN(10) || IN(11)) {
        LAS int* tile_e = (LAS int*)(lds + L_TILEE);
        int nt = 0;
        for (int e = 0; e < NEXP; ++e) { const int t0 = MOESEG[2 * e] >> 8, n = (MOESEG[2 * e + 1] + 255) >> 8; if (tid < n) tile_e[t0 + tid] = e; nt += n; }
        __syncthreads();
        if (IN(10)) {
            pg8::Gemm g{TPERM, W1, SLOT_MAX, NEXP * 1024, DM}; pg8::MoeOrder S{nt, G, bx, tile_e};
            pg8::EpiMoe1 E{ACT, DEXP};
            pg8::gemm_phase<pg8::EpiMoe1, pg8::MoeOrder, true, true>(lds, g, S, E);
            SEAM(10);
        }
        if (IN(11)) {
            pg8::Gemm g{ACT, W2, SLOT_MAX, NEXP * 1024, DEXP}; pg8::MoeOrder S{nt, G, bx, tile_e};
            pg8::EpiMoe2 E{out, DM, SLOTTOK, SLOTW, MOESEG};
            pg8::gemm_phase<pg8::EpiMoe2, pg8::MoeOrder, true, true>(lds, g, S, E);
        }
    }
#undef IN
#undef SEAM
}

extern "C" void kernel_launch(void* const* d_in, const int* in_sizes, int n_in, void* d_out, int out_size, void* d_ws, size_t ws_size, hipStream_t stream) {
    static int grid = 0;
    if (grid == 0) {
        if (n_in != 32 || out_size != NTOK * DM || ws_size < WS_END) { fprintf(stderr, "kernel_launch: unexpected shapes (n_in %d out %d ws %zu)\n", n_in, out_size, ws_size); grid = -1; return; }
        int dev = 0, cus = 0, per_cu = 0;
        if (hipGetDevice(&dev) != hipSuccess || hipDeviceGetAttribute(&cus, hipDeviceAttributeMultiprocessorCount, dev) != hipSuccess) { grid = -1; return; }
        if (hipFuncSetAttribute((const void*)mk_fwd, hipFuncAttributeMaxDynamicSharedMemorySize, LDS_BYTES) != hipSuccess) { fprintf(stderr, "kernel_launch: hipFuncSetAttribute failed\n"); grid = -1; return; }
        if (hipOccupancyMaxActiveBlocksPerMultiprocessor(&per_cu, (const void*)mk_fwd, NTHR, LDS_BYTES) != hipSuccess || per_cu < 1) { fprintf(stderr, "kernel_launch: occupancy query says %d\n", per_cu); }
        (void)hipGetLastError();
        grid = cus;
    }
    if (grid < 0) return;
    (void)hipMemsetAsync((char*)d_ws + WS_CTL, 0, CTL_ZERO_BYTES, stream);
    Args a{};
    for (int i = 0; i < 32; ++i) a.in[i] = (const float*)d_in[i];
    a.out = (float*)d_out; a.ws = (unsigned char*)d_ws;
#if MK_ONE_LAUNCH
    a.ph_lo = 0; a.ph_hi = MK_PH_END;
    hipLaunchKernelGGL(mk_fwd, dim3(grid), dim3(NTHR), LDS_BYTES, stream, a);
#else
    for (int p = 0; p < MK_PH_END; ++p) { a.ph_lo = p; a.ph_hi = p + 1; hipLaunchKernelGGL(mk_fwd, dim3(grid), dim3(NTHR), LDS_BYTES, stream, a); }
#endif
}
```

```cpp
#include <hip/hip_runtime.h>
#include <cstdio>
#include <cstdint>
namespace pg8 {
#define PG8_LAS __attribute__((address_space(3)))
typedef unsigned short bf16_t;
typedef short bf16x8 __attribute__((ext_vector_type(8)));
typedef float f32x4 __attribute__((ext_vector_type(4)));
typedef unsigned u32x4 __attribute__((ext_vector_type(4)));
constexpr int BM = 256, BK = 64, HALF = 128, HTB = HALF * BK * 2  , STAGE_BYTES = 8 * HTB, NXCD = 8, WGM = 8;

__host__ __device__ __forceinline__ int lds_byte(int r, int c) { const int st = (r >> 4) * 2 + (c >> 5), rr = r & 15, cc = c & 31, ob = rr * 64 + cc * 2; return st * 1024 + (ob ^ (((ob >> 9) & 1) << 5)); }
__host__ __device__ __forceinline__ void stage_rc(int b, int& R, int& C) { const int st = b / 1024, sb = b % 1024, swz = sb ^ (((sb >> 9) & 1) << 5); R = (st >> 1) * 16 + swz / 64; C = (st & 1) * 32 + (swz % 64) / 2; }
__host__ __device__ __forceinline__ int perm32(int rho) { const int n = rho >> 4, i = rho & 15; return 8 * (i >> 2) + 4 * n + (i & 3); }

struct Unit { int pm, pn; };
struct Gemm { const bf16_t* A; const bf16_t* Bt; int M, N, K; };

struct StaticOrder {
    int nM, nN, nwg, G, c;
    __host__ __device__ void init(int M, int N, int G_, int c_) { nM = M / BM; nN = N / BM; nwg = nM * nN; G = G_; c = c_; }
    __host__ __device__ bool next(int i, Unit& u) const {
        const long L = (long)i * G + c; if (L >= nwg) return false;
        int wgid = (int)L; { const int q = nwg / NXCD, r = nwg % NXCD, xcd = wgid % NXCD, off = wgid / NXCD; wgid = (xcd < r ? xcd * (q + 1) : r * (q + 1) + (xcd - r) * q) + off; }
        const int nig = WGM * nN, gid = wgid / nig, fm = gid * WGM, gsz = (nM - fm) < WGM ? (nM - fm) : WGM;
        u.pm = fm + ((wgid % nig) % gsz); u.pn = (wgid % nig) / gsz; return true;
    }
    __device__ __forceinline__ void a_ready(const Unit&) const {}
    __device__ __forceinline__ void done(const Unit&) const {}
};

__device__ __forceinline__ unsigned cvt_pk_bf16(float lo, float hi) { unsigned r; asm volatile("v_cvt_pk_bf16_f32 %0, %1, %2" : "=v"(r) : "v"(lo), "v"(hi)); return r; }
template <class Epi, class Sched, bool ALIGN_EPI = false, bool SP2 = false>
__device__ __forceinline__ void gemm_phase(PG8_LAS unsigned char* lds, const Gemm g, const Sched& S, const Epi& E) {
    const int tid = threadIdx.x, wid = __builtin_amdgcn_readfirstlane(tid >> 6), lane = tid & 63, wr = wid >> 2, wc = wid & 3, fr = lane & 15, fq = lane >> 4;
    const int K = g.K, nt = K / BK;
    unsigned voffA[2], voffB[2];
#pragma unroll
    for (int i = 0; i < 2; ++i) { int R, C; stage_rc(tid * 16 + i * 8192, R, C); const int Rb = Epi::PERM ? ((R & ~31) + perm32(R & 31)) : R;
        voffA[i] = (unsigned)(R * K + C) * 2u; voffB[i] = (unsigned)(Rb * K + C) * 2u; }
    const size_t kstep = (size_t)(BK * 2);
    const size_t hstep = (size_t)HALF * K * 2;
    const size_t tstep = 2 * hstep;
    const unsigned ldsw = (unsigned)wid * 1024u;
    const int aoff = lds_byte(wr * 64 + fr, fq * 8), boff = lds_byte(wc * 32 + fr, fq * 8);
#define PG8_SA(b, h) (((b) * 2 + (h)) * HTB)
#define PG8_SB(b, h) ((4 + (b) * 2 + (h)) * HTB)
#define PG8_STAGE(bufoff, gbase, voff) do { _Pragma("unroll") for (int _i = 0; _i < 2; ++_i) \
        __builtin_amdgcn_global_load_lds((const unsigned*)((const char*)(gbase) + (voff)[_i]), (PG8_LAS unsigned*)(lds + (bufoff) + ldsw + _i * 8192), 16, 0, 0); } while (0)
#define PG8_LDA(dst, b, h) do { _Pragma("unroll") for (int m = 0; m < 4; ++m) _Pragma("unroll") for (int k = 0; k < 2; ++k) dst[m][k] = *(const PG8_LAS bf16x8*)(lds + PG8_SA(b, h) + aoff + m * 2048 + k * 1024); } while (0)
#define PG8_LDB(dst, b, h) do { _Pragma("unroll") for (int n = 0; n < 2; ++n) _Pragma("unroll") for (int k = 0; k < 2; ++k) dst[n][k] = *(const PG8_LAS bf16x8*)(lds + PG8_SB(b, h) + boff + n * 2048 + k * 1024); } while (0)
#define PG8_MMA(ai, bj, At, Bt) do { __builtin_amdgcn_s_setprio(1); _Pragma("unroll") for (int m = 0; m < 4; ++m) _Pragma("unroll") for (int n = 0; n < 2; ++n) _Pragma("unroll") for (int k = 0; k < 2; ++k) \
        acc[ai][bj][m][n] = __builtin_amdgcn_mfma_f32_16x16x32_bf16(Bt[n][k], At[m][k], acc[ai][bj][m][n], 0, 0, 0); __builtin_amdgcn_s_setprio(0); } while (0)
#define PG8_WAIT_V(n) asm volatile("s_waitcnt vmcnt(" #n ")" ::: "memory")
#define PG8_WAIT_L(n) asm volatile("s_waitcnt lgkmcnt(" #n ")" ::: "memory")
#define PG8_BAR __builtin_amdgcn_s_barrier()
#define PG8_SCHED __builtin_amdgcn_sched_barrier(0)
    Unit cur, nxt; int ui = 0;
    if (!S.next(0, cur)) return;
    f32x4 acc[2][2][4][2];
#pragma unroll
    for (int a = 0; a < 2; ++a)
#pragma unroll
        for (int b = 0; b < 2; ++b)
#pragma unroll
            for (int m = 0; m < 4; ++m)
#pragma unroll
                for (int n = 0; n < 2; ++n) acc[a][b][m][n] = (f32x4){0.f, 0.f, 0.f, 0.f};
    bf16x8 At[4][2], B0[2][2], B1[2][2];
    const char* cA = (const char*)g.A + (size_t)cur.pm * tstep; const char* cB = (const char*)g.Bt + (size_t)cur.pn * tstep;
    S.a_ready(cur);
    if constexpr (SP2) {
        PG8_STAGE(PG8_SB(0, 0), cB, voffB); PG8_STAGE(PG8_SB(0, 1), cB + hstep, voffB); PG8_STAGE(PG8_SA(0, 0), cA, voffA); PG8_STAGE(PG8_SA(0, 1), cA + hstep, voffA);
        if (wr == 1) PG8_BAR;
        PG8_WAIT_V(2); PG8_BAR;
        PG8_STAGE(PG8_SB(1, 0), cB + kstep, voffB); PG8_STAGE(PG8_SA(1, 0), cA + kstep, voffA); PG8_STAGE(PG8_SB(1, 1), cB + hstep + kstep, voffB);
        PG8_WAIT_V(6); PG8_BAR;
    } else {
        PG8_STAGE(PG8_SB(0, 0), cB, voffB); PG8_STAGE(PG8_SA(0, 0), cA, voffA); PG8_STAGE(PG8_SB(0, 1), cB + hstep, voffB); PG8_STAGE(PG8_SA(0, 1), cA + hstep, voffA);
        if (wr == 1) PG8_BAR;
        PG8_WAIT_V(4); PG8_BAR;
        PG8_STAGE(PG8_SB(1, 0), cB + kstep, voffB); PG8_STAGE(PG8_SA(1, 0), cA + kstep, voffA); PG8_STAGE(PG8_SB(1, 1), cB + hstep + kstep, voffB);
        PG8_WAIT_V(6); PG8_BAR;
    }
    for (;;) {
        const bool has_next = S.next(ui + 1, nxt);
        const char* nA = has_next ? (const char*)g.A + (size_t)nxt.pm * tstep : cA; const char* nB = has_next ? (const char*)g.Bt + (size_t)nxt.pn * tstep : cB;
        for (int t = 0; t < nt; t += 2) {
            const bool last = (t == nt - 2);
            const char* a1 = cA + (size_t)(t + 1) * kstep;
            const char* a2 = last ? nA : cA + (size_t)(t + 2) * kstep; const char* b2 = last ? nB : cB + (size_t)(t + 2) * kstep;
            const char* a3 = a2 + kstep; const char* b3 = b2 + kstep;
            if (last && has_next) S.a_ready(nxt);
            if constexpr (SP2) {
            PG8_LDB(B0, 0, 0); PG8_LDB(B1, 0, 1); PG8_SCHED; PG8_LDA(At, 0, 0); PG8_STAGE(PG8_SA(1, 1), a1 + hstep, voffA);
            PG8_WAIT_V(8); PG8_WAIT_L(0); PG8_BAR; PG8_MMA(0, 0, At, B0); PG8_MMA(0, 1, At, B1); PG8_BAR; PG8_SCHED;
            PG8_LDA(At, 0, 1); PG8_STAGE(PG8_SB(0, 0), b2, voffB); PG8_STAGE(PG8_SB(0, 1), b2 + hstep, voffB); PG8_STAGE(PG8_SA(0, 0), a2, voffA);
            PG8_WAIT_V(8); PG8_WAIT_L(0); PG8_BAR; PG8_MMA(1, 0, At, B0); PG8_MMA(1, 1, At, B1); PG8_BAR; PG8_SCHED;
            PG8_LDB(B0, 1, 0); PG8_LDB(B1, 1, 1); PG8_SCHED; PG8_LDA(At, 1, 0); PG8_STAGE(PG8_SA(0, 1), a2 + hstep, voffA);
            PG8_WAIT_V(8); PG8_WAIT_L(0); PG8_BAR; PG8_MMA(0, 0, At, B0); PG8_MMA(0, 1, At, B1); PG8_BAR; PG8_SCHED;
            PG8_LDA(At, 1, 1); PG8_STAGE(PG8_SB(1, 0), b3, voffB); PG8_STAGE(PG8_SB(1, 1), b3 + hstep, voffB); PG8_STAGE(PG8_SA(1, 0), a3, voffA);
            PG8_WAIT_V(8); PG8_WAIT_L(0); PG8_BAR; PG8_MMA(1, 0, At, B0); PG8_MMA(1, 1, At, B1); PG8_BAR; PG8_SCHED;
            } else {
            PG8_LDB(B0, 0, 0); PG8_SCHED; PG8_LDA(At, 0, 0); PG8_STAGE(PG8_SA(1, 1), a1 + hstep, voffA);
            PG8_WAIT_L(8); PG8_BAR; PG8_WAIT_L(0); PG8_MMA(0, 0, At, B0); PG8_BAR; PG8_SCHED;
            PG8_LDB(B1, 0, 1); PG8_STAGE(PG8_SB(0, 0), b2, voffB);
            PG8_BAR; PG8_WAIT_L(0); PG8_MMA(0, 1, At, B1); PG8_BAR;
            PG8_LDA(At, 0, 1); PG8_STAGE(PG8_SA(0, 0), a2, voffA);
            PG8_BAR; PG8_WAIT_L(0); PG8_MMA(1, 0, At, B0); PG8_BAR; PG8_SCHED;
            PG8_STAGE(PG8_SB(0, 1), b2 + hstep, voffB);
            PG8_WAIT_V(6); PG8_BAR; PG8_MMA(1, 1, At, B1); PG8_BAR;
            PG8_LDB(B0, 1, 0); PG8_SCHED; PG8_LDA(At, 1, 0); PG8_STAGE(PG8_SA(0, 1), a2 + hstep, voffA);
            PG8_WAIT_L(8); PG8_BAR; PG8_WAIT_L(0); PG8_MMA(0, 0, At, B0); PG8_BAR; PG8_SCHED;
            PG8_LDB(B1, 1, 1); PG8_STAGE(PG8_SB(1, 0), b3, voffB);
            PG8_BAR; PG8_WAIT_L(0); PG8_MMA(0, 1, At, B1); PG8_BAR;
            PG8_LDA(At, 1, 1); PG8_STAGE(PG8_SA(1, 0), a3, voffA);
            PG8_BAR; PG8_WAIT_L(0); PG8_MMA(1, 0, At, B0); PG8_BAR; PG8_SCHED;
            PG8_STAGE(PG8_SB(1, 1), b3 + hstep, voffB);
            PG8_WAIT_V(6); PG8_BAR; PG8_MMA(1, 1, At, B1); PG8_BAR;
            }
        }
        if constexpr (ALIGN_EPI) { if (wr == 0) PG8_BAR; }
        if constexpr (!Epi::AFTER_DRAIN) { E(acc, cur, wr, wc, fr, fq); S.done(cur); }
        if (!has_next) break;
#pragma unroll
        for (int a = 0; a < 2; ++a)
#pragma unroll
            for (int b = 0; b < 2; ++b)
#pragma unroll
                for (int m = 0; m < 4; ++m)
#pragma unroll
                    for (int n = 0; n < 2; ++n) acc[a][b][m][n] = (f32x4){0.f, 0.f, 0.f, 0.f};
        cur = nxt; cA = nA; cB = nB; ++ui;
        if constexpr (ALIGN_EPI) { if (wr == 1) PG8_BAR; }
    }
    PG8_WAIT_V(0);
    if constexpr (!ALIGN_EPI) { if (wr == 0) PG8_BAR; }
    PG8_BAR;
    if constexpr (Epi::AFTER_DRAIN) { E.fused(acc, cur, wr, wc, fr, fq, lds, wid, lane); S.done(cur); }
#undef PG8_SA
#undef PG8_SB
#undef PG8_STAGE
#undef PG8_LDA
#undef PG8_LDB
#undef PG8_MMA
#undef PG8_WAIT_V
#undef PG8_WAIT_L
#undef PG8_BAR
#undef PG8_SCHED
}
}
namespace pg8 {
struct EpiBf16SS {
    static constexpr bool PERM = true, AFTER_DRAIN = false;
    bf16_t* O; int ldc; float* SS; int ssld; unsigned ssmask; int pnmask;
    __device__ __forceinline__ void operator()(const f32x4 (&acc)[2][2][4][2], const Unit& u, int wr, int wc, int fr, int fq) const {
        const int row0 = u.pm * BM + wr * 64 + fr, col0 = (u.pn & pnmask) * BM + wc * 32 + 8 * fq;
        const bool doss = ((ssmask >> u.pn) & 1u) != 0u;
#pragma unroll
        for (int ai = 0; ai < 2; ++ai)
#pragma unroll
            for (int m = 0; m < 4; ++m) { const int row = row0 + ai * HALF + m * 16; bf16_t* rowp = O + (size_t)row * ldc + col0;
#pragma unroll
                for (int bj = 0; bj < 2; ++bj) { const f32x4 v0 = acc[ai][bj][m][0], v1 = acc[ai][bj][m][1];
                    u32x4 w; w.x = cvt_pk_bf16(v0[0], v0[1]); w.y = cvt_pk_bf16(v0[2], v0[3]); w.z = cvt_pk_bf16(v1[0], v1[1]); w.w = cvt_pk_bf16(v1[2], v1[3]);
                    *(u32x4*)(rowp + bj * HALF) = w;
                    if (doss) { float s = (v0[0] * v0[0] + v0[1] * v0[1]) + (v0[2] * v0[2] + v0[3] * v0[3]) + (v1[0] * v1[0] + v1[1] * v1[1]) + (v1[2] * v1[2] + v1[3] * v1[3]);
                        s += __shfl_xor(s, 16); s += __shfl_xor(s, 32);
                        if (fq == 0) SS[(size_t)row * ssld + ((u.pn * BM + bj * HALF + wc * 32) >> 5)] = s; } } }
    }
};
struct EpiResF32 {
    static constexpr bool PERM = false, AFTER_DRAIN = false;
    const float* base; float* out; int ldc;
    __device__ __forceinline__ void operator()(const f32x4 (&acc)[2][2][4][2], const Unit& u, int wr, int wc, int fr, int fq) const {
        const int col0 = u.pn * BM + wc * 32 + 4 * fq;
#pragma unroll
        for (int ai = 0; ai < 2; ++ai)
#pragma unroll
            for (int m = 0; m < 4; ++m) { const size_t off = (size_t)(u.pm * BM + ai * HALF + wr * 64 + m * 16 + fr) * ldc + col0;
#pragma unroll
                for (int bj = 0; bj < 2; ++bj)
#pragma unroll
                    for (int n = 0; n < 2; ++n) { const f32x4 bs = *(const f32x4*)(base + off + bj * HALF + n * 16); *(f32x4*)(out + off + bj * HALF + n * 16) = bs + acc[ai][bj][m][n]; }
                if (m & 1) asm volatile("" ::: "memory"); }
    }
};
struct EpiMoe1 {
    static constexpr bool PERM = true, AFTER_DRAIN = false;
    bf16_t* ACT; int ldc;
    __device__ __forceinline__ void operator()(const f32x4 (&acc)[2][2][4][2], const Unit& u, int wr, int wc, int fr, int fq) const {
        const int row0 = u.pm * BM + wr * 64 + fr, col0 = (u.pn & 3) * HALF + wc * 32 + 8 * fq;
#pragma unroll
        for (int ai = 0; ai < 2; ++ai)
#pragma unroll
            for (int m = 0; m < 4; ++m) { float a[8];
#pragma unroll
                for (int n = 0; n < 2; ++n)
#pragma unroll
                    for (int e = 0; e < 4; ++e) { const float g = acc[ai][0][m][n][e], up = acc[ai][1][m][n][e]; a[n * 4 + e] = g * __builtin_amdgcn_rcpf(1.0f + __expf(-g)) * up; }
                u32x4 w; w.x = cvt_pk_bf16(a[0], a[1]); w.y = cvt_pk_bf16(a[2], a[3]); w.z = cvt_pk_bf16(a[4], a[5]); w.w = cvt_pk_bf16(a[6], a[7]);
                *(u32x4*)(ACT + (size_t)(row0 + ai * HALF + m * 16) * ldc + col0) = w; }
    }
};
struct EpiMoe2 {
    static constexpr bool PERM = false, AFTER_DRAIN = false;
    float* out; int ldc; const int* slot_tok; const float* slot_w; const int* seg;
    __device__ __forceinline__ void operator()(const f32x4 (&acc)[2][2][4][2], const Unit& u, int wr, int wc, int fr, int fq) const {
        const int e = u.pn >> 2, send = seg[2 * e] + seg[2 * e + 1];
        const int col0 = (u.pn & 3) * BM + wc * 32 + 4 * fq;
#pragma unroll
        for (int ai = 0; ai < 2; ++ai)
#pragma unroll
            for (int m = 0; m < 4; ++m) { const int slot = u.pm * BM + ai * HALF + wr * 64 + m * 16 + fr;
                if (slot < send) { const int tok = slot_tok[slot]; const float w = slot_w[slot]; float* op = out + (size_t)tok * ldc + col0;
#pragma unroll
                    for (int bj = 0; bj < 2; ++bj)
#pragma unroll
                        for (int n = 0; n < 2; ++n)
#pragma unroll
                            for (int q = 0; q < 4; ++q) unsafeAtomicAdd(op + bj * HALF + n * 16 + q, w * acc[ai][bj][m][n][q]); } }
    }
};
struct MoeOrder {
    int ntile, G, c; const PG8_LAS int* tile_e;
    __device__ __forceinline__ bool next(int i, Unit& u) const {
        const int L = i * G + c; if (L >= ntile * 4) return false;
        const int ti = L >> 2; u.pm = ti; u.pn = __builtin_amdgcn_readfirstlane(tile_e[ti]) * 4 + (L & 3); return true;
    }
    __device__ __forceinline__ void a_ready(const Unit&) const {}
    __device__ __forceinline__ void done(const Unit&) const {}
};
}
namespace att {
#define ALAS __attribute__((address_space(3)))
typedef unsigned short bf16_t;
typedef short bf16x8 __attribute__((ext_vector_type(8)));
typedef short s16x4 __attribute__((ext_vector_type(4)));
typedef float f32x16 __attribute__((ext_vector_type(16)));
typedef float f32x4 __attribute__((ext_vector_type(4)));
typedef unsigned u32x4 __attribute__((ext_vector_type(4)));
enum { FOX = 0, DIFF = 1, CROSS = 2 };
constexpr int SUBT = 16384;
constexpr float LOG2E = 1.4426950408889634f, NEPS = 1e-6f, THR = 8.f;
constexpr int SEQ = 2048, PROJW = 3072, DM = 1024, NMEM = 256;
constexpr int BT_N = 320, BT_OFF = 224;

template <int T> struct AC;
template <> struct AC<FOX>   { static constexpr int NKS = 8,  ROWS = 256, KSUB = 1, VSUB = 1; };
template <> struct AC<DIFF>  { static constexpr int NKS = 4,  ROWS = 128, KSUB = 1, VSUB = 1; };
template <> struct AC<CROSS> { static constexpr int NKS = 16, ROWS = 128, KSUB = 2, VSUB = 2; };

__device__ __forceinline__ int kswz(int row, int colB) { return row * 256 + (colB ^ ((row & 7) << 4)); }
__device__ __forceinline__ int v_st(int k, int c) { const int kk = (k & ~0xC) | ((k & 4) << 1) | ((k & 8) >> 1); return ((kk >> 3) * 4 + (c >> 5)) * 512 + ((kk & 7) * 32 + (c & 31)) * 2; }
__device__ __forceinline__ int v_rd_base(int lane) { return ((lane & 3) << 3) | (((lane >> 2) & 3) << 6) | (((lane >> 4) & 1) << 5) | (((lane >> 5) & 1) << 8); }
__device__ __forceinline__ int crow(int r, int hi) { return (r & 3) + 8 * (r >> 2) + 4 * hi; }
__device__ __forceinline__ unsigned cvtpk(float lo, float hi) { unsigned r; asm volatile("v_cvt_pk_bf16_f32 %0, %1, %2" : "=v"(r) : "v"(lo), "v"(hi)); return r; }
__device__ __forceinline__ float bflo(unsigned w) { return __uint_as_float(w << 16); }
__device__ __forceinline__ float bfhi(unsigned w) { return __uint_as_float(w & 0xffff0000u); }
#define ASBAR() __builtin_amdgcn_sched_barrier(0)

__device__ __forceinline__ bf16x8 qprep(u32x4 raw, float s, const ALAS float* G) {
    const f32x4 g0 = *(const ALAS f32x4*)G, g1 = *(const ALAS f32x4*)(G + 4);
    u32x4 w;
    w.x = cvtpk(bflo(raw.x) * s * g0[0], bfhi(raw.x) * s * g0[1]); w.y = cvtpk(bflo(raw.y) * s * g0[2], bfhi(raw.y) * s * g0[3]);
    w.z = cvtpk(bflo(raw.z) * s * g1[0], bfhi(raw.z) * s * g1[1]); w.w = cvtpk(bflo(raw.w) * s * g1[2], bfhi(raw.w) * s * g1[3]);
    return __builtin_bit_cast(bf16x8, w);
}

struct Ptrs {
    const bf16_t* PROJ;  const float* SS;
    const float* NEGC;
    const bf16_t* QC;    const float* SSQC;
    const bf16_t* KVC;   const float* SSKV;
    bf16_t* MIX;         bf16_t* CO;
    const float* g_fox_out; const float* g_subln;
    float lam, one_m_lam_init;
};

template <int T> constexpr int tilesz() { return (AC<T>::KSUB + AC<T>::VSUB) * SUBT; }
constexpr int KT_OFF_SELF = 65536, KT_OFF_CROSS = 131072;
__device__ __forceinline__ void dma16(const void* g, ALAS unsigned char* l) { __builtin_amdgcn_global_load_lds((const unsigned*)g, (ALAS unsigned*)l, 16, 0, 0); }
template <int T>
__device__ __forceinline__ void attn_unit(const Ptrs& P, int b, int h, int blk, ALAS unsigned char* lds, ALAS float* wsf, const ALAS float* GQ, const ALAS float* BT) {
    constexpr int NKS = AC<T>::NKS, ROWS = AC<T>::ROWS, KSUB = AC<T>::KSUB, VSUB = AC<T>::VSUB, BUFSZ = tilesz<T>();
    constexpr int KT_OFF = (T == CROSS) ? KT_OFF_CROSS : KT_OFF_SELF, STG_OFF = (T == CROSS) ? 0 : 65536;
    int tid_ = threadIdx.x; asm volatile("" : "+v"(tid_));
    const int tid = tid_, wid = __builtin_amdgcn_readfirstlane(tid >> 6), lane = tid & 63, r32 = lane & 31, hi = lane >> 5;
    const int rg = (T == FOX) ? wid : (wid & 3), sel = (T == FOX) ? 0 : (wid >> 2);
    const int P0 = blk * ROWS, qlo = P0 + 32 * rg;
    const int NT = (T == CROSS) ? NMEM / 64 : (P0 + ROWS) / 64;
    const bf16_t* Kp; const bf16_t* Vp; int kvpitch; const float* SSk; int sskld;
    if constexpr (T == FOX)  { Kp = P.PROJ + (size_t)b * SEQ * PROJW + 2048 + h * 128; Vp = Kp + 512; kvpitch = PROJW; SSk = P.SS + (size_t)b * SEQ * 96 + 64 + 4 * h; sskld = 96; }
    if constexpr (T == DIFF) { Kp = P.PROJ + (size_t)b * SEQ * PROJW + 512 + h * 128;  Vp = Kp + 512; kvpitch = PROJW; SSk = P.SS + (size_t)b * SEQ * 96 + 16 + 4 * h; sskld = 96; }
    if constexpr (T == CROSS){ Kp = P.KVC + (size_t)b * NMEM * 2048 + h * 256;         Vp = Kp + 1024; kvpitch = 2048; SSk = P.SSKV + (size_t)b * NMEM * 64 + 8 * h; sskld = 64; }
    ALAS float* KT = (ALAS float*)(lds + KT_OFF);
    for (int k = tid; k < NT * 64; k += 512) {
        const f32x4 s4 = *(const f32x4*)(SSk + (size_t)k * sskld);
        if constexpr (T == FOX)   { KT[k] = __builtin_amdgcn_rsqf(((s4[0] + s4[1]) + (s4[2] + s4[3])) * (1.f / 128.f) + NEPS); KT[2048 + k] = P.NEGC[(size_t)(b * 4 + h) * SEQ + k]; }
        if constexpr (T == DIFF)  { KT[k] = __builtin_amdgcn_rsqf((s4[0] + s4[1]) * (1.f / 64.f) + NEPS); KT[2048 + k] = __builtin_amdgcn_rsqf((s4[2] + s4[3]) * (1.f / 64.f) + NEPS); }
        if constexpr (T == CROSS) { const f32x4 s5 = *(const f32x4*)(SSk + (size_t)k * sskld + 4); KT[k] = __builtin_amdgcn_rsqf((((s4[0] + s4[1]) + (s4[2] + s4[3])) + ((s5[0] + s5[1]) + (s5[2] + s5[3]))) * (1.f / 256.f) + NEPS); }
    }
    int koff[2], voff[2];
#pragma unroll
    for (int i = 0; i < 2; ++i) { const int pi = 2 * wid + i;
        { const int row = pi * 4 + (lane >> 4), lc = (lane & 15) ^ (row & 7); koff[i] = row * kvpitch + lc * 8; }
        { const int st = pi * 2 + (lane >> 5), kk = (st >> 2) * 8 + ((lane >> 2) & 7), c = (st & 3) * 32 + (lane & 3) * 8;
          const int k = (kk & ~0xC) | ((kk & 4) << 1) | ((kk & 8) >> 1); voff[i] = k * kvpitch + c; } }
#define A_DMA(t, bf) do { const size_t to_ = (size_t)(t) * 64 * kvpitch; ALAS unsigned char* d_ = lds + (bf) * BUFSZ + wid * 2048; \
        _Pragma("unroll") for (int s_ = 0; s_ < KSUB; ++s_) { dma16(Kp + to_ + s_ * 128 + koff[0], d_ + s_ * SUBT); dma16(Kp + to_ + s_ * 128 + koff[1], d_ + s_ * SUBT + 1024); } \
        _Pragma("unroll") for (int s_ = 0; s_ < VSUB; ++s_) { dma16(Vp + to_ + s_ * 128 + voff[0], d_ + (KSUB + s_) * SUBT); dma16(Vp + to_ + s_ * 128 + voff[1], d_ + (KSUB + s_) * SUBT + 1024); } } while (0)
    A_DMA(0, 0);
    bf16x8 qr[NKS];
    {
        const int qrow = qlo + r32; float ssq; const bf16_t* qp;
        const size_t tok = (size_t)b * SEQ + qrow;
        if constexpr (T == FOX)  { const f32x4 s4 = *(const f32x4*)(P.SS + tok * 96 + 48 + 4 * h); ssq = ((s4[0] + s4[1]) + (s4[2] + s4[3])) * (1.f / 128.f); qp = P.PROJ + tok * PROJW + 1536 + h * 128; }
        if constexpr (T == DIFF) { const float* sp = P.SS + tok * 96 + 4 * h + 2 * sel; ssq = (sp[0] + sp[1]) * (1.f / 64.f); qp = P.PROJ + tok * PROJW + h * 128 + sel * 64; }
        if constexpr (T == CROSS){ const f32x4 s4 = *(const f32x4*)(P.SSQC + tok * 32 + 8 * h), s5 = *(const f32x4*)(P.SSQC + tok * 32 + 8 * h + 4);
                                   ssq = (((s4[0] + s4[1]) + (s4[2] + s4[3])) + ((s5[0] + s5[1]) + (s5[2] + s5[3]))) * (1.f / 256.f); qp = P.QC + tok * DM + h * 256; }
        const float rq = __builtin_amdgcn_rsqf(ssq + NEPS);
#pragma unroll
        for (int ks = 0; ks < NKS; ++ks) { const u32x4 raw = *(const u32x4*)(qp + ks * 16 + hi * 8); qr[ks] = qprep(raw, rq, GQ + ks * 16 + hi * 8); }
    }
    float m_reg = -1e30f, l_reg = 0.f; f32x16 o[4];
#pragma unroll
    for (int d = 0; d < 4; ++d) o[d] = f32x16{};
    const int vbl = v_rd_base(lane);
    for (int t = 0; t < NT; ++t) {
        const int cur = t & 1, kb = t * 64;
        asm volatile("s_waitcnt vmcnt(0)" ::: "memory");
        __syncthreads();
        if (t + 1 < NT) A_DMA(t + 1, cur ^ 1);
        ALAS unsigned char* tb = lds + cur * BUFSZ;
        bool act;
        if constexpr (T == FOX)  act = (kb <= qlo + 31);
        if constexpr (T == DIFF) act = (t <= (qlo >> 6));
        if constexpr (T == CROSS) act = true;
        if (act) {
            f32x16 p0 = f32x16{}, p1 = f32x16{};
            {
                const ALAS unsigned char* kt = tb + ((T == DIFF) ? sel * 128 : 0);
#pragma unroll
                for (int ks = 0; ks < NKS; ++ks) {
                    const int sub = ks >> 3, dd = ks & 7;
                    const ALAS unsigned char* a = kt + sub * SUBT + kswz(r32, ((dd & 3) * 16 + hi * 8) * 2) + (dd >> 2) * 128;
                    const bf16x8 b0 = *(const ALAS bf16x8*)a, b1 = *(const ALAS bf16x8*)(a + 32 * 256);
                    p0 = __builtin_amdgcn_mfma_f32_32x32x16_bf16(b0, qr[ks], p0, 0, 0, 0);
                    p1 = __builtin_amdgcn_mfma_f32_32x32x16_bf16(b1, qr[ks], p1, 0, 0, 0);
                }
            }
            {
                const ALAS float* rkp = KT + ((T == DIFF) ? sel * 2048 : 0) + kb + 4 * hi;
                const bool near = (T == DIFF) ? (kb + 63 - qlo > -128) : false;
                const ALAS float* btp = BT + (kb - qlo + BT_OFF + 4 * hi - r32);
                const float bfar = (T == DIFF) ? BT[0] : 0.f;
#pragma unroll
                for (int g = 0; g < 4; ++g) {
                    const f32x4 rk0 = *(const ALAS f32x4*)(rkp + 8 * g), rk1 = *(const ALAS f32x4*)(rkp + 32 + 8 * g);
                    f32x4 a0 = {0.f, 0.f, 0.f, 0.f}, a1 = {0.f, 0.f, 0.f, 0.f};
                    if constexpr (T == FOX)  { a0 = *(const ALAS f32x4*)(rkp + 2048 + 8 * g); a1 = *(const ALAS f32x4*)(rkp + 2048 + 32 + 8 * g); }
                    if constexpr (T == DIFF) { if (near) { a0 = (f32x4){btp[8 * g], btp[8 * g + 1], btp[8 * g + 2], btp[8 * g + 3]}; a1 = (f32x4){btp[32 + 8 * g], btp[33 + 8 * g], btp[34 + 8 * g], btp[35 + 8 * g]}; }
                                               else { a0 = (f32x4){bfar, bfar, bfar, bfar}; a1 = a0; } }
#pragma unroll
                    for (int e = 0; e < 4; ++e) { p0[4 * g + e] = __builtin_fmaf(p0[4 * g + e], rk0[e], a0[e]); p1[4 * g + e] = __builtin_fmaf(p1[4 * g + e], rk1[e], a1[e]); }
                }
                if constexpr (T == FOX) {
                    if (kb + 63 > qlo) {
                        const float NEG = -__builtin_inff(); const int dq = qlo + r32 - kb - 4 * hi;
#pragma unroll
                        for (int r = 0; r < 16; ++r) { const int c = (r & 3) + 8 * (r >> 2); if (c > dq) p0[r] = NEG; if (c + 32 > dq) p1[r] = NEG; }
                    }
                }
            }
            float alpha;
            {
                float pmax = p0[0];
#pragma unroll
                for (int r = 1; r < 16; ++r) pmax = fmaxf(pmax, p0[r]);
#pragma unroll
                for (int r = 0; r < 16; ++r) pmax = fmaxf(pmax, p1[r]);
                { auto rr = __builtin_amdgcn_permlane32_swap(__float_as_uint(pmax), __float_as_uint(pmax), false, false); pmax = fmaxf(__uint_as_float(rr[0]), __uint_as_float(rr[1])); }
                if (__builtin_expect(__all(pmax - m_reg <= THR), 1)) { alpha = 1.f; }
                else { const float mn = fmaxf(m_reg, pmax); alpha = __builtin_amdgcn_exp2f(m_reg - mn); m_reg = mn; }
#pragma unroll
                for (int r = 0; r < 16; ++r) { p0[r] = __builtin_amdgcn_exp2f(p0[r] - m_reg); p1[r] = __builtin_amdgcn_exp2f(p1[r] - m_reg); }
                float ps = 0.f;
#pragma unroll
                for (int r = 0; r < 16; ++r) ps += p0[r] + p1[r];
                { auto rr = __builtin_amdgcn_permlane32_swap(__float_as_uint(ps), __float_as_uint(ps), false, false); ps = __uint_as_float(rr[0]) + __uint_as_float(rr[1]); }
                l_reg = l_reg * alpha + ps;
            }
            bf16x8 pa0, pa1, pa2, pa3;
#define A_PK4(Pv, B_, OUT) do { unsigned a0_ = cvtpk(Pv[B_ + 0], Pv[B_ + 1]), a1_ = cvtpk(Pv[B_ + 2], Pv[B_ + 3]), b0_ = cvtpk(Pv[B_ + 4], Pv[B_ + 5]), b1_ = cvtpk(Pv[B_ + 6], Pv[B_ + 7]); \
        auto r0_ = __builtin_amdgcn_permlane32_swap(a0_, b0_, false, false); auto r1_ = __builtin_amdgcn_permlane32_swap(a1_, b1_, false, false); \
        u32x4 w_ = {r0_[0], r1_[0], r0_[1], r1_[1]}; OUT = __builtin_bit_cast(bf16x8, w_); } while (0)
            A_PK4(p0, 0, pa0); A_PK4(p0, 8, pa1); A_PK4(p1, 0, pa2); A_PK4(p1, 8, pa3);
#undef A_PK4
            if (__any(alpha < 1.f)) {
                if (hi == 0) wsf[r32] = alpha;
                asm volatile("s_waitcnt lgkmcnt(0)" ::: "memory");
#pragma unroll
                for (int r = 0; r < 16; ++r) { const float al = wsf[crow(r, hi)];
#pragma unroll
                    for (int d = 0; d < 4; ++d) o[d][r] *= al; }
            }
            {
                const int vb0 = (int)(unsigned)(size_t)(tb + (KSUB + ((T == CROSS) ? sel : 0)) * SUBT) + vbl;
#define A_TRRD(dst, off) asm volatile("ds_read_b64_tr_b16 %0, %1 offset:%2" : "=&v"(dst) : "v"(vb0), "i"(off) : "memory")
#define A_PV(d0) do { s16x4 l0, l1, l2, l3, h0, h1, h2, h3; constexpr int b_ = (d0) * 512; \
        A_TRRD(l0, b_); A_TRRD(h0, b_ + 2048); A_TRRD(l1, b_ + 4096); A_TRRD(h1, b_ + 6144); A_TRRD(l2, b_ + 8192); A_TRRD(h2, b_ + 10240); A_TRRD(l3, b_ + 12288); A_TRRD(h3, b_ + 14336); \
        asm volatile("s_waitcnt lgkmcnt(0)" ::: "memory"); ASBAR(); \
        o[d0] = __builtin_amdgcn_mfma_f32_32x32x16_bf16(pa0, (bf16x8){l0[0], l0[1], l0[2], l0[3], h0[0], h0[1], h0[2], h0[3]}, o[d0], 0, 0, 0); \
        o[d0] = __builtin_amdgcn_mfma_f32_32x32x16_bf16(pa1, (bf16x8){l1[0], l1[1], l1[2], l1[3], h1[0], h1[1], h1[2], h1[3]}, o[d0], 0, 0, 0); \
        o[d0] = __builtin_amdgcn_mfma_f32_32x32x16_bf16(pa2, (bf16x8){l2[0], l2[1], l2[2], l2[3], h2[0], h2[1], h2[2], h2[3]}, o[d0], 0, 0, 0); \
        o[d0] = __builtin_amdgcn_mfma_f32_32x32x16_bf16(pa3, (bf16x8){l3[0], l3[1], l3[2], l3[3], h3[0], h3[1], h3[2], h3[3]}, o[d0], 0, 0, 0); } while (0)
                A_PV(0); A_PV(1); A_PV(2); A_PV(3);
#undef A_PV
#undef A_TRRD
            }
        }
    }
#undef A_DMA
    __syncthreads();
    if (hi == 0) wsf[32 + r32] = l_reg;
    asm volatile("s_waitcnt lgkmcnt(0)" ::: "memory");
#pragma unroll
    for (int r = 0; r < 16; ++r) { const float rl = __builtin_amdgcn_rcpf(wsf[32 + crow(r, hi)]);
#pragma unroll
        for (int d = 0; d < 4; ++d) o[d][r] *= rl; }
    if constexpr (T == DIFF) {
        ALAS float* hnd = (ALAS float*)lds + (size_t)rg * 4096 + lane;
        if (sel == 1) {
#pragma unroll
            for (int d = 0; d < 4; ++d)
#pragma unroll
                for (int r = 0; r < 16; ++r) hnd[(d * 16 + r) * 64] = o[d][r];
        }
        __syncthreads();
        if (sel == 0) {
#pragma unroll
            for (int d = 0; d < 4; ++d)
#pragma unroll
                for (int r = 0; r < 16; ++r) o[d][r] = o[d][r] - P.lam * hnd[(d * 16 + r) * 64];
        }
    }
    if (T == CROSS || sel == 0) {
        float gcol[4]; bf16_t* op;
        if constexpr (T == FOX)  { op = P.MIX + ((size_t)b * SEQ + qlo) * DM + 512 + h * 128;
#pragma unroll
            for (int d = 0; d < 4; ++d) gcol[d] = P.g_fox_out[32 * d + r32]; }
        if constexpr (T == DIFF) { op = P.MIX + ((size_t)b * SEQ + qlo) * DM + h * 128;
#pragma unroll
            for (int d = 0; d < 4; ++d) gcol[d] = P.g_subln[32 * d + r32] * P.one_m_lam_init; }
        if constexpr (T == CROSS){ op = P.CO + ((size_t)b * SEQ + qlo) * DM + h * 256 + sel * 128;
#pragma unroll
            for (int d = 0; d < 4; ++d) gcol[d] = 1.f; }
        ALAS bf16_t* stg = (ALAS bf16_t*)(lds + STG_OFF) + ((T == DIFF) ? rg : wid) * 4096;
#pragma unroll
        for (int r = 0; r < 16; ++r) {
            float rs = 1.f;
            if constexpr (T != CROSS) {
                float s = (o[0][r] * o[0][r] + o[1][r] * o[1][r]) + (o[2][r] * o[2][r] + o[3][r] * o[3][r]);
                s += __shfl_xor(s, 1); s += __shfl_xor(s, 2); s += __shfl_xor(s, 4); s += __shfl_xor(s, 8); s += __shfl_xor(s, 16);
                rs = __builtin_amdgcn_rsqf(s * (1.f / 128.f) + NEPS);
            }
            const int orow = crow(r, hi);
#pragma unroll
            for (int d = 0; d < 4; ++d) { const unsigned w = cvtpk(o[d][r] * rs * gcol[d], 0.f); stg[orow * 128 + 32 * d + r32] = (bf16_t)(w & 0xffffu); }
        }
        asm volatile("s_waitcnt lgkmcnt(0)" ::: "memory");
#pragma unroll
        for (int i = 0; i < 8; ++i) { const int row = i * 4 + (lane >> 4), ch = lane & 15; const u32x4 v = *(const ALAS u32x4*)(stg + row * 128 + ch * 8); *(u32x4*)(op + (size_t)row * DM + ch * 8) = v; }
    }
    __syncthreads();
}
#undef ASBAR
}
constexpr int NWAVES = 8, NTHR = NWAVES * 64;
constexpr int BATCH = 8, SEQ = 2048, DM = 1024, NTOK = BATCH * SEQ, NMEM = 256, MROWS = BATCH * NMEM;
constexpr int INCOLS = 3076, PROJW = 3072, NEXP = 16, DEXP = 512;
constexpr int SLOT_MAX = 2 * NTOK + NEXP * 256;
constexpr float EPS = 1e-6f, LOG2E = 1.4426950408889634f;
#ifndef MK_ONE_LAUNCH
#define MK_ONE_LAUNCH 1
#endif
#ifndef MK_PH_END
#define MK_PH_END 13
#endif
constexpr int N_PHASES = 13;
constexpr size_t MiB = 1u << 20, KiB = 1u << 10;
constexpr size_t WS_CTL = 0, CTL_ZERO_BYTES = 1 * MiB;
constexpr size_t WS_WIN = 2 * MiB, WS_WOUT = 8 * MiB, WS_WCQ = 10 * MiB, WS_WCKV = 12 * MiB, WS_WCO = 16 * MiB, WS_W1 = 18 * MiB, WS_W2 = 50 * MiB;
constexpr size_t WS_MEMN = 66 * MiB, WS_KVC = 70 * MiB, WS_SS = 78 * MiB, WS_H = 84 * MiB, WS_PROJ = 116 * MiB, WS_ACT = 212 * MiB, WS_SM = 248 * MiB, WS_END = 256 * MiB;
constexpr size_t WS_QC = WS_PROJ, WS_CO = WS_PROJ + 32 * MiB, WS_TPERM = WS_PROJ, WS_Y = WS_PROJ;
constexpr size_t WS_NEGC = WS_SM, WS_LOGF = WS_SM + 256 * KiB, WS_CHOICE = WS_SM + 512 * KiB, WS_SLOTTOK = WS_SM + 768 * KiB, WS_SLOTW = WS_SM + 928 * KiB,
                 WS_CHUNKCNT = WS_SM + 1088 * KiB, WS_MOESEG = WS_SM + 1104 * KiB, WS_TOKSLOT = WS_SM + 1152 * KiB, WS_SSKV = WS_SM + 2 * MiB, WS_SSQC = WS_SM + 3 * MiB;
static_assert(WS_TPERM + (size_t)SLOT_MAX * DM * 2 <= WS_ACT && WS_ACT + (size_t)SLOT_MAX * DEXP * 2 <= WS_SM && WS_SSQC + (size_t)NTOK * 32 * 4 <= WS_END, "d_ws map");
constexpr int CW_TMO = 0, CW_QFOX = 64, CW_QDIFF = 128, CW_BAR = 4096;
constexpr int RING_BYTES = 133120;
constexpr int L_WSF = RING_BYTES, L_GQ = L_WSF + 2048, L_BT = L_GQ + 1024, L_MISC = L_BT + 4 * att::BT_N * 4, L_TILEE = L_MISC + 256, LDS_BYTES = 147456;
static_assert(RING_BYTES >= pg8::STAGE_BYTES && L_TILEE + 160 * 4 <= LDS_BYTES, "LDS map");

#define GAS __attribute__((address_space(1)))
#define LAS __attribute__((address_space(3)))
typedef unsigned short bf16;
typedef unsigned v4u __attribute__((ext_vector_type(4)));
typedef float f32x4 __attribute__((ext_vector_type(4)));
typedef short bf16x8 __attribute__((ext_vector_type(8)));
typedef GAS unsigned gu32;
typedef GAS unsigned long long gu64;
#define RLX_AGENT __ATOMIC_RELAXED, __HIP_MEMORY_SCOPE_AGENT
#define LDS_WAIT() asm volatile("s_waitcnt lgkmcnt(0)" ::: "memory")
#define VM_WAIT() asm volatile("s_waitcnt vmcnt(0)" ::: "memory")
__device__ __forceinline__ unsigned long long rt() { return __builtin_amdgcn_s_memrealtime(); }
__device__ __forceinline__ unsigned f2bf(float f) { unsigned u = __builtin_bit_cast(unsigned, f); return (u + 0x7fffu + ((u >> 16) & 1u)) >> 16; }
__device__ __forceinline__ unsigned pk2(float lo, float hi) { return f2bf(lo) | (f2bf(hi) << 16); }
#define XB_TMO      128
#define XB_XCNT(j)  (256  + 64 * (j))
#define XB_XSUB(j)  (1280 + 64 * (j))
#define XB_XGEN(j)  (2304 + 64 * (j))
#define XB_TOP      3328
#define XB_TOPGEN   3392
#define XCD_BAR_WORDS 3456
#define XB_SPIN_CAP (1u << 18)

__device__ __forceinline__ unsigned xb_ld(unsigned* p)              { return __hip_atomic_load(p, __ATOMIC_RELAXED, __HIP_MEMORY_SCOPE_AGENT); }
__device__ __forceinline__ unsigned xb_add(unsigned* p, unsigned v) { return __hip_atomic_fetch_add(p, v, __ATOMIC_RELAXED, __HIP_MEMORY_SCOPE_AGENT); }
__device__ __forceinline__ unsigned xb_xcc_id() { return (unsigned)__builtin_amdgcn_s_getreg((3 << 11) | 20) & 0xFu; }
#define XB_SPIN(cond, bar) do { unsigned _sp = 0; while (cond) { __builtin_amdgcn_s_sleep(1); \
    if ((++_sp & 255u) == 0u) { if (xb_ld(&(bar)[XB_TMO])) break; if (_sp > XB_SPIN_CAP) { atomicAdd(&(bar)[XB_TMO], 1u); break; } } } } while (0)

struct XcdBarrier {
    unsigned* bar; unsigned x;
    volatile LAS unsigned* st;
};

__device__ __forceinline__ XcdBarrier xcd_barrier_post(unsigned* bar, volatile LAS unsigned* st) {
    XcdBarrier b; b.bar = bar; b.x = xb_xcc_id(); b.st = st;
    if (threadIdx.x == 0) (void)xb_add(&bar[XB_XCNT(b.x)], 1u);
    return b;
}
__device__ __forceinline__ void xcd_barrier_complete(unsigned* bar, unsigned x, unsigned& nloc, unsigned& nx) {
    const unsigned G = gridDim.x * gridDim.y * gridDim.z;
    unsigned sum, cnt, mine, sp = 0u;
    for (;;) {
        sum = 0u; cnt = 0u; mine = 0u;
#pragma unroll
        for (unsigned j = 0; j < 16; ++j) { const unsigned c = xb_ld(&bar[XB_XCNT(j)]); sum += c; cnt += (c > 0u) ? 1u : 0u; mine = (j == x) ? c : mine; }
        if (sum == G) break;
        __builtin_amdgcn_s_sleep(1);
        if ((++sp & 255u) == 0u) { if (xb_ld(&bar[XB_TMO])) break; if (sp > XB_SPIN_CAP) { atomicAdd(&bar[XB_TMO], 1u); break; } }
    }
    nloc = mine > 0u ? mine : 1u; nx = cnt > 0u ? cnt : 1u;
}

__device__ __forceinline__ void xcd_barrier(const XcdBarrier& b) {
    asm volatile("s_waitcnt vmcnt(0)" ::: "memory");
    __syncthreads();
    if (threadIdx.x == 0) {
        unsigned* bar = b.bar;
        __builtin_amdgcn_s_waitcnt(0);
        unsigned nloc = b.st[0], nx = b.st[1];
        if (nloc == 0u) { xcd_barrier_complete(bar, b.x, nloc, nx); b.st[0] = nloc; b.st[1] = nx; }
        const unsigned old = xb_add(&bar[XB_XSUB(b.x)], 1u);
        const unsigned gen = old / nloc;
        if (old + 1u == (gen + 1u) * nloc) {
            __builtin_amdgcn_fence(__ATOMIC_RELEASE, "agent");
            asm volatile("s_waitcnt vmcnt(0)" ::: "memory");
            const unsigned og = xb_add(&bar[XB_TOP], 1u);
            const unsigned tg = og / nx;
            if (og + 1u == (tg + 1u) * nx) xb_add(&bar[XB_TOPGEN], 1u);
            else XB_SPIN(xb_ld(&bar[XB_TOPGEN]) == tg, bar);
            __builtin_amdgcn_fence(__ATOMIC_ACQUIRE, "agent");
            xb_add(&bar[XB_XGEN(b.x)], 1u);
            asm volatile("s_waitcnt vmcnt(0)" ::: "memory");
        } else {
            XB_SPIN(xb_ld(&bar[XB_XGEN(b.x)]) == gen, bar);
            __builtin_amdgcn_fence(__ATOMIC_ACQUIRE, "agent");
            asm volatile("s_waitcnt vmcnt(0)" ::: "memory");
        }
    }
    __syncthreads();
}

__device__ __forceinline__ float wave_sum(float v) {
#pragma unroll
    for (int o = 1; o < 64; o <<= 1) v += __shfl_xor(v, o);
    return v;
}
__device__ __forceinline__ void tr_item(const float* W, int ldw, int k0, int n0, bf16* WT, int drow0, int K, LAS float* scr, int lane) {
#pragma unroll 8
    for (int i = 0; i < 32; ++i) { const int kk = 2 * i + (lane >> 5); scr[kk * 33 + (lane & 31)] = W[(size_t)(k0 + kk) * ldw + n0 + (lane & 31)]; }
    LDS_WAIT(); asm volatile("" ::: "memory");
    const int c = lane & 7;
#pragma unroll
    for (int j = 0; j < 4; ++j) { const int n = (lane >> 3) + 8 * j; const LAS float* s = scr + (8 * c) * 33 + n;
        v4u o; o.x = pk2(s[0 * 33], s[1 * 33]); o.y = pk2(s[2 * 33], s[3 * 33]); o.z = pk2(s[4 * 33], s[5 * 33]); o.w = pk2(s[6 * 33], s[7 * 33]);
        *(GAS v4u*)(WT + (size_t)(drow0 + n) * K + k0 + 8 * c) = o; }
    LDS_WAIT(); asm volatile("" ::: "memory");
}
__device__ __forceinline__ float row_load_rstd(const float* xrow, int lane, f32x4 (&v)[4]) {
    const GAS f32x4* xr = (const GAS f32x4*)xrow + lane; float s = 0.f;
#pragma unroll
    for (int j = 0; j < 4; ++j) { v[j] = xr[64 * j]; s += (v[j].x * v[j].x + v[j].y * v[j].y) + (v[j].z * v[j].z + v[j].w * v[j].w); }
    return 1.0f / sqrtf(wave_sum(s) * (1.f / DM) + EPS);
}
__device__ __forceinline__ void row_store_bf16(bf16* orow, int lane, const f32x4 (&v)[4]) {
    GAS unsigned long long* o8 = (GAS unsigned long long*)orow + lane;
#pragma unroll
    for (int j = 0; j < 4; ++j) o8[64 * j] = (unsigned long long)pk2(v[j].x, v[j].y) | ((unsigned long long)pk2(v[j].z, v[j].w) << 32);
}
__device__ __forceinline__ int t5_bucket(int rel) {
    const int ret = rel > 0 ? 16 : 0, n = rel < 0 ? -rel : rel;
    int v;
    if (n < 8) v = n; else if (n < 12) v = 8; else if (n < 16) v = 9; else if (n < 23) v = 10; else if (n < 32) v = 11; else if (n < 46) v = 12; else if (n < 64) v = 13; else if (n < 91) v = 14; else v = 15;
    return ret + v;
}

struct Args { const float* in[32]; float* out; unsigned char* ws; int ph_lo, ph_hi, li, pad; };
__global__ void __launch_bounds__(NTHR, 2) mk_fwd(Args args) {
    extern __shared__ __attribute__((aligned(16))) unsigned char lds_raw[];
    LAS unsigned char* lds = (LAS unsigned char*)lds_raw;
    volatile LAS unsigned* MISC = (volatile LAS unsigned*)(lds + L_MISC);
    const int tid = threadIdx.x, lane = tid & 63, wave = __builtin_amdgcn_readfirstlane(tid >> 6);
    const int G = gridDim.x, bx = blockIdx.x;
    unsigned char* ws = args.ws;
    gu32* ctl = (gu32*)(ws + WS_CTL);
    float* out = args.out;
    bf16* W_IN = (bf16*)(ws + WS_WIN); bf16* W_OUT = (bf16*)(ws + WS_WOUT); bf16* W_CQ = (bf16*)(ws + WS_WCQ); bf16* W_CKV = (bf16*)(ws + WS_WCKV); bf16* W_CO = (bf16*)(ws + WS_WCO);
    bf16* W1 = (bf16*)(ws + WS_W1); bf16* W2 = (bf16*)(ws + WS_W2);
    bf16* MEMN = (bf16*)(ws + WS_MEMN); bf16* KVC = (bf16*)(ws + WS_KVC); float* SS = (float*)(ws + WS_SS); bf16* H = (bf16*)(ws + WS_H); bf16* PROJ = (bf16*)(ws + WS_PROJ);
    bf16* ACT = (bf16*)(ws + WS_ACT); bf16* QC = (bf16*)(ws + WS_QC); bf16* CO = (bf16*)(ws + WS_CO); bf16* TPERM = (bf16*)(ws + WS_TPERM);
    float* NEGC = (float*)(ws + WS_NEGC); float* LOGF = (float*)(ws + WS_LOGF); float* SSKV = (float*)(ws + WS_SSKV); float* SSQC = (float*)(ws + WS_SSQC);
    int* CHOICE = (int*)(ws + WS_CHOICE); int* SLOTTOK = (int*)(ws + WS_SLOTTOK); float* SLOTW = (float*)(ws + WS_SLOTW); int* CHUNKCNT = (int*)(ws + WS_CHUNKCNT); int* MOESEG = (int*)(ws + WS_MOESEG); int* TOKSLOT = (int*)(ws + WS_TOKSLOT); bf16* Y = (bf16*)(ws + WS_Y);

    for (int u = tid; u < (LDS_BYTES - L_MISC) / 4; u += NTHR) ((LAS unsigned*)(lds + L_MISC))[u] = 0u;
    __syncthreads();
    XcdBarrier bar; bar.bar = (unsigned*)(ctl + CW_BAR) + args.li * XCD_BAR_WORDS; bar.x = 0; bar.st = nullptr;
    if (MK_ONE_LAUNCH) bar = xcd_barrier_post((unsigned*)(ctl + CW_BAR) + args.li * XCD_BAR_WORDS, MISC + 8);
    const int lo = args.ph_lo, hi = args.ph_hi;
#ifndef MK_PHMASK
#define MK_PHMASK 0x1FFF
#endif
#define IN(k) (((MK_PHMASK >> (k)) & 1) && lo <= (k) && (k) < hi)
#define SEAM(k) do { if (MK_ONE_LAUNCH && IN((k) + 1)) xcd_barrier(bar); } while (0)

    if (IN(0)) {
        const int gw = bx * NWAVES + wave, NGW = G * NWAVES;
        LAS float* scr = (LAS float*)(lds + wave * 8704);
        LAS float* wf = (LAS float*)(lds + 73728);
        const float* w_in = args.in[4];
        for (int i = tid; i < 4096; i += NTHR) { const int k = i >> 2, j = i & 3; wf[j * 1024 + k] = w_in[(size_t)k * INCOLS + PROJW + j]; }
        constexpr int I_IN = 16 * 96, I_SQ = 16 * 32, I_CKV = 16 * 64, I_E = 16 * 256;
        constexpr int NITEMS = I_IN + 3 * I_SQ + I_CKV + 3 * I_E;
        for (int it = gw; it < NITEMS; it += NGW) {
            int r = it;
            if (r < I_IN) { tr_item(w_in, INCOLS, 64 * (r / 96), 32 * (r % 96), W_IN, 32 * (r % 96), DM, scr, lane); continue; } r -= I_IN;
            if (r < I_SQ) { tr_item(args.in[16], DM, 64 * (r / 32), 32 * (r % 32), W_OUT, 32 * (r % 32), DM, scr, lane); continue; } r -= I_SQ;
            if (r < I_SQ) { tr_item(args.in[19], DM, 64 * (r / 32), 32 * (r % 32), W_CQ, 32 * (r % 32), DM, scr, lane); continue; } r -= I_SQ;
            if (r < I_SQ) { tr_item(args.in[23], DM, 64 * (r / 32), 32 * (r % 32), W_CO, 32 * (r % 32), DM, scr, lane); continue; } r -= I_SQ;
            if (r < I_CKV) { tr_item(args.in[20], 2 * DM, 64 * (r / 64), 32 * (r % 64), W_CKV, 32 * (r % 64), DM, scr, lane); continue; } r -= I_CKV;
            if (r < 2 * I_E) {
                const int up = r >= I_E ? 1 : 0; r -= up * I_E; const int e = r >> 8, q = r & 255, kb = q >> 4, nb = q & 15, c0 = 32 * nb;
                const float* src = (up ? args.in[30] : args.in[29]) + (size_t)e * DM * DEXP;
                tr_item(src, DEXP, 64 * kb, c0, W1, e * 1024 + (c0 >> 7) * 256 + up * 128 + (c0 & 127), DM, scr, lane); continue; } r -= 2 * I_E;
            { const int e = r >> 8, q = r & 255, kb = q >> 5, nb = q & 31;
              tr_item(args.in[31] + (size_t)e * DEXP * DM, DM, 64 * kb, 32 * nb, W2, e * 1024 + 32 * nb, DEXP, scr, lane); }
        }
        __syncthreads();
        {
            const float* x = args.in[0]; const float* g = args.in[3]; const float* bfg = args.in[5];
            f32x4 gv[4];
#pragma unroll
            for (int j = 0; j < 4; ++j) gv[j] = *((const GAS f32x4*)g + lane + 64 * j);
            for (int m = gw; m < NTOK; m += NGW) {
                f32x4 v[4]; const float rstd = row_load_rstd(x + (size_t)m * DM, lane, v);
                float d0 = 0.f, d1 = 0.f, d2 = 0.f, d3 = 0.f;
#pragma unroll
                for (int j = 0; j < 4; ++j) { v[j] = v[j] * rstd * gv[j];
                    const f32x4 w0 = *(const LAS f32x4*)(wf + 4 * lane + 256 * j), w1 = *(const LAS f32x4*)(wf + 1024 + 4 * lane + 256 * j), w2 = *(const LAS f32x4*)(wf + 2048 + 4 * lane + 256 * j), w3 = *(const LAS f32x4*)(wf + 3072 + 4 * lane + 256 * j);
                    d0 += (v[j].x * w0.x + v[j].y * w0.y) + (v[j].z * w0.z + v[j].w * w0.w); d1 += (v[j].x * w1.x + v[j].y * w1.y) + (v[j].z * w1.z + v[j].w * w1.w);
                    d2 += (v[j].x * w2.x + v[j].y * w2.y) + (v[j].z * w2.z + v[j].w * w2.w); d3 += (v[j].x * w3.x + v[j].y * w3.y) + (v[j].z * w3.z + v[j].w * w3.w); }
                row_store_bf16(H + (size_t)m * DM, lane, v);
                d0 = wave_sum(d0); d1 = wave_sum(d1); d2 = wave_sum(d2); d3 = wave_sum(d3);
                if (lane < 4) { const float z = (lane == 0 ? d0 : lane == 1 ? d1 : lane == 2 ? d2 : d3) + bfg[lane];
                    const float ls = fminf(z, 0.f) - log1pf(expf(-fabsf(z)));
                    LOGF[(size_t)((m >> 11) * 4 + lane) * SEQ + (m & (SEQ - 1))] = ls; }
            }
        }
        {
            const float* mem = args.in[1]; const float* g = args.in[18];
            f32x4 gv[4];
#pragma unroll
            for (int j = 0; j < 4; ++j) gv[j] = *((const GAS f32x4*)g + lane + 64 * j);
            for (int m = gw; m < MROWS; m += NGW) { f32x4 v[4]; const float rstd = row_load_rstd(mem + (size_t)m * DM, lane, v);
#pragma unroll
                for (int j = 0; j < 4; ++j) v[j] = v[j] * rstd * gv[j];
                row_store_bf16(MEMN + (size_t)m * DM, lane, v); }
        }
        SEAM(0);
    }

    if (IN(1)) {
        for (int bh = bx; bh < BATCH * 4; bh += G) {
            LAS float* wt = (LAS float*)lds;
            const f32x4 v = *(const f32x4*)(LOGF + (size_t)bh * SEQ + 4 * tid);
            const float c0 = v.x, c1 = c0 + v.y, c2 = c1 + v.z, c3 = c2 + v.w;
            float s = c3;
#pragma unroll
            for (int o = 1; o < 64; o <<= 1) { const float n = __shfl_up(s, o); if (lane >= o) s += n; }
            if (lane == 63) wt[wave] = s;
            __syncthreads();
            float base = s - c3;
            for (int w = 0; w < wave; ++w) base += wt[w];
            *(f32x4*)(NEGC + (size_t)bh * SEQ + 4 * tid) = (f32x4){-(base + c0) * LOG2E, -(base + c1) * LOG2E, -(base + c2) * LOG2E, -(base + c3) * LOG2E};
            __syncthreads();
        }
        { pg8::Gemm g{H, W_IN, NTOK, PROJW, DM}; pg8::StaticOrder S; S.init(NTOK, PROJW, G, bx);
          pg8::EpiBf16SS E{PROJ, PROJW, SS, 96, 0x3CFu, -1};
          pg8::gemm_phase<pg8::EpiBf16SS, pg8::StaticOrder, true, true>(lds, g, S, E); }
        { pg8::Gemm g{MEMN, W_CKV, MROWS, 2 * DM, DM}; pg8::StaticOrder S; S.init(MROWS, 2 * DM, G, bx);
          pg8::EpiBf16SS E{KVC, 2 * DM, SSKV, 64, 0x0Fu, -1};
          pg8::gemm_phase<pg8::EpiBf16SS, pg8::StaticOrder, true, true>(lds, g, S, E); }
        SEAM(1);
    }

    if (IN(2)) {
        att::Ptrs P; P.PROJ = PROJ; P.SS = SS; P.NEGC = NEGC; P.QC = QC; P.SSQC = SSQC; P.KVC = KVC; P.SSKV = SSKV; P.MIX = H; P.CO = CO;
        P.g_fox_out = args.in[15]; P.g_subln = args.in[12];
        { float a = args.in[8][lane] * args.in[9][lane], c = args.in[10][lane] * args.in[11][lane]; a = wave_sum(a); c = wave_sum(c);
          const float lam_init = 0.8f - 0.6f; P.lam = expf(a) - expf(c) + lam_init; P.one_m_lam_init = 1.0f - lam_init; }
        LAS float* wsf = (LAS float*)(lds + L_WSF) + wave * 64; LAS float* GQ = (LAS float*)(lds + L_GQ); LAS float* BT = (LAS float*)(lds + L_BT);
        if (tid < 128) GQ[tid] = args.in[13][tid] * args.in[14][tid] * (0.08838834764831845f * LOG2E);
        __syncthreads();
        for (;;) {
            if (tid == 0) MISC[0] = __hip_atomic_fetch_add(ctl + CW_QFOX + 256 * args.li, 1u, RLX_AGENT);
            __syncthreads();
            const int it = (int)MISC[0];
            __syncthreads();
            if (it >= 256) break;
            const int blk = 7 - (it >> 5), bh = it & 31;
#ifndef MK_NO_FOX
            att::attn_unit<att::FOX>(P, bh >> 2, bh & 3, blk, lds, wsf, GQ, BT);
#endif
        }
        __syncthreads();
        if (tid < 64) GQ[tid] = args.in[6][tid] * args.in[7][tid] * (0.125f * LOG2E);
        for (int i = tid; i < 4 * att::BT_N; i += NTHR) { const int hh = i / att::BT_N, rel = i % att::BT_N - att::BT_OFF; BT[i] = args.in[2][t5_bucket(rel) * 4 + hh] * LOG2E; }
        __syncthreads();
        for (;;) {
            if (tid == 0) MISC[0] = __hip_atomic_fetch_add(ctl + CW_QDIFF + 256 * args.li, 1u, RLX_AGENT);
            __syncthreads();
            const int it = (int)MISC[0];
            __syncthreads();
            if (it >= 512) break;
            const int blk = 15 - (it >> 5), bh = it & 31;
#ifndef MK_NO_DIFF
            att::attn_unit<att::DIFF>(P, bh >> 2, bh & 3, blk, lds, wsf, GQ, BT + (bh & 3) * att::BT_N);
#endif
        }
        SEAM(2);
    }

    if (IN(3)) {
        pg8::Gemm g{H, W_OUT, NTOK, DM, DM}; pg8::StaticOrder S; S.init(NTOK, DM, G, bx);
        pg8::EpiResF32 E{args.in[0], out, DM};
        pg8::gemm_phase<pg8::EpiResF32, pg8::StaticOrder, true, true>(lds, g, S, E);
        SEAM(3);
    }

    if (IN(4)) {
        const int gw = bx * NWAVES + wave, NGW = G * NWAVES; const float* g = args.in[17];
        f32x4 gv[4];
#pragma unroll
        for (int j = 0; j < 4; ++j) gv[j] = *((const GAS f32x4*)g + lane + 64 * j);
        for (int m = gw; m < NTOK; m += NGW) { f32x4 v[4]; const float rstd = row_load_rstd(out + (size_t)m * DM, lane, v);
#pragma unroll
            for (int j = 0; j < 4; ++j) v[j] = v[j] * rstd * gv[j];
            row_store_bf16(H + (size_t)m * DM, lane, v); }
        SEAM(4);
    }

    if (IN(5)) {
        pg8::Gemm g{H, W_CQ, NTOK, DM, DM}; pg8::StaticOrder S; S.init(NTOK, DM, G, bx);
        pg8::EpiBf16SS E{QC, DM, SSQC, 32, 0xFu, -1};
        pg8::gemm_phase<pg8::EpiBf16SS, pg8::StaticOrder, true, true>(lds, g, S, E);
        SEAM(5);
    }

    if (IN(6)) {
        att::Ptrs P; P.PROJ = PROJ; P.SS = SS; P.NEGC = NEGC; P.QC = QC; P.SSQC = SSQC; P.KVC = KVC; P.SSKV = SSKV; P.MIX = H; P.CO = CO;
        P.g_fox_out = args.in[15]; P.g_subln = args.in[12]; P.lam = 0.f; P.one_m_lam_init = 1.f;
        LAS float* wsf = (LAS float*)(lds + L_WSF) + wave * 64; LAS float* GQ = (LAS float*)(lds + L_GQ); LAS float* BT = (LAS float*)(lds + L_BT);
        if (tid < 256) GQ[tid] = args.in[21][tid] * args.in[22][tid] * (0.0625f * LOG2E);
        __syncthreads();
        for (int it = bx; it < 512; it += G) { const int bh = it >> 4, blk = it & 15; att::attn_unit<att::CROSS>(P, bh >> 2, bh & 3, blk, lds, wsf, GQ, BT); }
        SEAM(6);
    }

    if (IN(7)) {
        pg8::Gemm g{CO, W_CO, NTOK, DM, DM}; pg8::StaticOrder S; S.init(NTOK, DM, G, bx);
        pg8::EpiResF32 E{out, out, DM};
        pg8::gemm_phase<pg8::EpiResF32, pg8::StaticOrder, true, true>(lds, g, S, E);
        SEAM(7);
    }

    if (IN(8)) {
        LAS float* WR = (LAS float*)lds;
        LAS int* cntL = (LAS int*)(lds + 20 * 1024 * 4);
        for (int i = tid; i < 4096; i += NTHR) WR[(i & 3) * 1024 + (i >> 2)] = args.in[25][i];
        for (int i = tid; i < 16384; i += NTHR) WR[(4 + (i & 15)) * 1024 + (i >> 4)] = args.in[27][i];
        const float* g = args.in[24]; const float* bgr = args.in[26]; const float* ber = args.in[28];
        f32x4 gv[4];
#pragma unroll
        for (int j = 0; j < 4; ++j) gv[j] = *((const GAS f32x4*)g + lane + 64 * j);
        for (int c = bx; c < NTOK / 64; c += G) {
            if (tid < 16) cntL[tid] = 0;
            __syncthreads();
            for (int i = 0; i < 8; ++i) {
                const int m = c * 64 + wave * 8 + i;
                f32x4 v[4]; const float rstd = row_load_rstd(out + (size_t)m * DM, lane, v);
#pragma unroll
                for (int j = 0; j < 4; ++j) v[j] = v[j] * rstd * gv[j];
                row_store_bf16(H + (size_t)m * DM, lane, v);
                float lg[20];
#pragma unroll
                for (int q = 0; q < 20; ++q) { float a = 0.f;
#pragma unroll
                    for (int j = 0; j < 4; ++j) { const f32x4 w = *(const LAS f32x4*)(WR + q * 1024 + 4 * lane + 256 * j); a += (v[j].x * w.x + v[j].y * w.y) + (v[j].z * w.z + v[j].w * w.w); }
                    lg[q] = wave_sum(a); }
                float gl[4]; int gi = 0;
#pragma unroll
                for (int q = 0; q < 4; ++q) gl[q] = lg[q] + bgr[q];
                float gm = gl[0];
#pragma unroll
                for (int q = 1; q < 4; ++q) if (gl[q] > gm) { gm = gl[q]; gi = q; }
                float gs = 0.f;
#pragma unroll
                for (int q = 0; q < 4; ++q) gs += expf(gl[q] - gm);
                const float pg = 1.0f / gs;
                float el[4];
#pragma unroll
                for (int q = 0; q < 4; ++q) { float sv = lg[4 + q] + ber[q];
#pragma unroll
                    for (int gg = 1; gg < 4; ++gg) sv = (gi == gg) ? lg[4 + 4 * gg + q] + ber[4 * gg + q] : sv;
                    el[q] = sv; }
                int i0 = 0; float m0 = el[0];
#pragma unroll
                for (int q = 1; q < 4; ++q) if (el[q] > m0) { m0 = el[q]; i0 = q; }
                int i1 = -1; float m1 = -__builtin_inff();
#pragma unroll
                for (int q = 0; q < 4; ++q) if (q != i0 && el[q] > m1) { m1 = el[q]; i1 = q; }
                const float e1 = expf(m1 - m0), w0 = pg / (1.0f + e1), w1 = pg * e1 / (1.0f + e1);
                if (lane == 0) { const int ea = gi * 4 + i0, eb = gi * 4 + i1; *(int4*)(CHOICE + (size_t)m * 4) = make_int4(ea, eb, __float_as_int(w0), __float_as_int(w1));
                    __hip_atomic_fetch_add(cntL + ea, 1, __ATOMIC_RELAXED, __HIP_MEMORY_SCOPE_WORKGROUP); __hip_atomic_fetch_add(cntL + eb, 1, __ATOMIC_RELAXED, __HIP_MEMORY_SCOPE_WORKGROUP); }
            }
            __syncthreads();
            if (tid < 16) CHUNKCNT[c * 16 + tid] = cntL[tid];
            __syncthreads();
        }
        SEAM(8);
    }

    if (IN(9)) {
        LAS int* cc = (LAS int*)lds;
        LAS int* tot = cc + 4096; LAS int* pre = tot + 16; LAS int* segs = pre + 16; LAS int* chL = segs + 16; LAS int* slotL = chL + 256;
        for (int i = tid; i < 4096; i += NTHR) cc[i] = CHUNKCNT[i];
        __syncthreads();
        if (tid < 16) { int s = 0; for (int c = 0; c < 256; ++c) s += cc[c * 16 + tid]; tot[tid] = s; }
        __syncthreads();
        if (tid < 16) { int st = 0; for (int e = 0; e < tid; ++e) st += (tot[e] + 255) & ~255; segs[tid] = st; }
        __syncthreads();
        if (bx == 0 && tid < 16) { MOESEG[2 * tid] = segs[tid]; MOESEG[2 * tid + 1] = tot[tid]; }
        for (int c = bx; c < NTOK / 64; c += G) {
            if (tid < 16) { int s = 0; for (int c2 = 0; c2 < c; ++c2) s += cc[c2 * 16 + tid]; pre[tid] = segs[tid] + s; }
            if (tid < 256) chL[tid] = CHOICE[(size_t)c * 256 + tid];
            __syncthreads();
            if (tid < 16) { int pos = pre[tid];
                for (int i = 0; i < 64; ++i) { if (chL[i * 4] == tid) slotL[i * 2] = pos++; if (chL[i * 4 + 1] == tid) slotL[i * 2 + 1] = pos++; } }
            __syncthreads();
            for (int i = 0; i < 8; ++i) { const int tl = wave * 8 + i, m = c * 64 + tl;
                const v4u a = *((const GAS v4u*)(H + (size_t)m * DM) + lane), b = *((const GAS v4u*)(H + (size_t)m * DM) + 64 + lane);
#pragma unroll
                for (int k = 0; k < 2; ++k) { const int slot = slotL[tl * 2 + k];
                    *((GAS v4u*)(TPERM + (size_t)slot * DM) + lane) = a; *((GAS v4u*)(TPERM + (size_t)slot * DM) + 64 + lane) = b;
                    if (lane == 0) { SLOTTOK[slot] = m; SLOTW[slot] = __int_as_float(chL[tl * 4 + 2 + k]); TOKSLOT[m * 2 + k] = slot; } } }
            __syncthreads();
        }
        SEAM(9);
    }

    if (IN(10) || IN(11)) {
        LAS int* tile_e = (LAS int*)(lds + L_TILEE);
        int nt = 0;
        for (int e = 0; e < NEXP; ++e) { const int t0 = MOESEG[2 * e] >> 8, n = (MOESEG[2 * e + 1] + 255) >> 8; if (tid < n) tile_e[t0 + tid] = e; nt += n; }
        __syncthreads();
        if (IN(10)) {
            pg8::Gemm g{TPERM, W1, SLOT_MAX, NEXP * 1024, DM}; pg8::MoeOrder S{nt, G, bx, tile_e};
            pg8::EpiMoe1 E{ACT, DEXP};
            pg8::gemm_phase<pg8::EpiMoe1, pg8::MoeOrder, true, true>(lds, g, S, E);
            SEAM(10);
        }
        if (IN(11)) {
            pg8::Gemm g{ACT, W2, SLOT_MAX, NEXP * 1024, DEXP}; pg8::MoeOrder S{nt, G, bx, tile_e};
            pg8::EpiBf16SS E{Y, DM, nullptr, 0, 0u, 3};
            pg8::gemm_phase<pg8::EpiBf16SS, pg8::MoeOrder, true, true>(lds, g, S, E);
            SEAM(11);
        }
    }

    if (IN(12)) {
        const int gw = bx * NWAVES + wave, NGW = G * NWAVES;
        for (int m = gw; m < NTOK; m += NGW) {
            const int4 ch = *(const int4*)(CHOICE + (size_t)m * 4); const int s0 = TOKSLOT[m * 2], s1 = TOKSLOT[m * 2 + 1];
            const float w0 = __int_as_float(ch.z), w1 = __int_as_float(ch.w);
            GAS f32x4* orow = (GAS f32x4*)(out + (size_t)m * DM) + lane;
            const GAS unsigned long long* y0 = (const GAS unsigned long long*)(Y + (size_t)s0 * DM) + lane; const GAS unsigned long long* y1 = (const GAS unsigned long long*)(Y + (size_t)s1 * DM) + lane;
#pragma unroll
            for (int j = 0; j < 4; ++j) { f32x4 v = orow[64 * j]; const unsigned long long a = y0[64 * j], b = y1[64 * j];
                const unsigned a0 = (unsigned)a, a1 = (unsigned)(a >> 32), b0 = (unsigned)b, b1 = (unsigned)(b >> 32);
                v.x += w0 * __uint_as_float(a0 << 16) + w1 * __uint_as_float(b0 << 16); v.y += w0 * __uint_as_float(a0 & 0xffff0000u) + w1 * __uint_as_float(b0 & 0xffff0000u);
                v.z += w0 * __uint_as_float(a1 << 16) + w1 * __uint_as_float(b1 << 16); v.w += w0 * __uint_as_float(a1 & 0xffff0000u) + w1 * __uint_as_float(b1 & 0xffff0000u);
                orow[64 * j] = v; }
        }
    }
#undef IN
#undef SEAM
}

extern "C" void kernel_launch(void* const* d_in, const int* in_sizes, int n_in, void* d_out, int out_size, void* d_ws, size_t ws_size, hipStream_t stream) {
    static int grid = 0;
    if (grid == 0) {
        if (n_in != 32 || out_size != NTOK * DM || ws_size < WS_END) { fprintf(stderr, "kernel_launch: unexpected shapes (n_in %d out %d ws %zu)\n", n_in, out_size, ws_size); grid = -1; return; }
        int dev = 0, cus = 0, per_cu = 0;
        if (hipGetDevice(&dev) != hipSuccess || hipDeviceGetAttribute(&cus, hipDeviceAttributeMultiprocessorCount, dev) != hipSuccess) { grid = -1; return; }
        if (hipFuncSetAttribute((const void*)mk_fwd, hipFuncAttributeMaxDynamicSharedMemorySize, LDS_BYTES) != hipSuccess) { fprintf(stderr, "kernel_launch: hipFuncSetAttribute failed\n"); grid = -1; return; }
        if (hipOccupancyMaxActiveBlocksPerMultiprocessor(&per_cu, (const void*)mk_fwd, NTHR, LDS_BYTES) != hipSuccess || per_cu < 1) { fprintf(stderr, "kernel_launch: occupancy query says %d\n", per_cu); }
        (void)hipGetLastError();
        grid = cus;
    }
    if (grid < 0) return;
    (void)hipMemsetAsync((char*)d_ws + WS_CTL, 0, CTL_ZERO_BYTES, stream);
    Args a{};
    for (int i = 0; i < 32; ++i) a.in[i] = (const float*)d_in[i];
    a.out = (float*)d_out; a.ws = (unsigned char*)d_ws;
#if defined(MK_REP)
    a.ph_lo = 0; a.ph_hi = MK_REP + 1; a.li = 0;
    hipLaunchKernelGGL(mk_fwd, dim3(grid), dim3(NTHR), LDS_BYTES, stream, a);
    a.ph_lo = MK_REP; a.ph_hi = MK_PH_END; a.li = 1;
    hipLaunchKernelGGL(mk_fwd, dim3(grid), dim3(NTHR), LDS_BYTES, stream, a);
#elif MK_ONE_LAUNCH
    a.ph_lo = 0; a.ph_hi = MK_PH_END;
    hipLaunchKernelGGL(mk_fwd, dim3(grid), dim3(NTHR), LDS_BYTES, stream, a);
#else
    for (int p = 0; p < MK_PH_END; ++p) { a.ph_lo = p; a.ph_hi = p + 1; hipLaunchKernelGGL(mk_fwd, dim3(grid), dim3(NTHR), LDS_BYTES, stream, a); }
#endif
}
```

```cpp
#include <hip/hip_runtime.h>
#include <cstdio>
#include <cstdint>
namespace pg8 {
#define PG8_LAS __attribute__((address_space(3)))
typedef unsigned short bf16_t;
typedef short bf16x8 __attribute__((ext_vector_type(8)));
typedef float f32x4 __attribute__((ext_vector_type(4)));
typedef unsigned u32x4 __attribute__((ext_vector_type(4)));
constexpr int BM = 256, BK = 64, HALF = 128, HTB = HALF * BK * 2  , STAGE_BYTES = 8 * HTB, NXCD = 8, WGM = 8;

__host__ __device__ __forceinline__ int lds_byte(int r, int c) { const int st = (r >> 4) * 2 + (c >> 5), rr = r & 15, cc = c & 31, ob = rr * 64 + cc * 2; return st * 1024 + (ob ^ (((ob >> 9) & 1) << 5)); }
__host__ __device__ __forceinline__ void stage_rc(int b, int& R, int& C) { const int st = b / 1024, sb = b % 1024, swz = sb ^ (((sb >> 9) & 1) << 5); R = (st >> 1) * 16 + swz / 64; C = (st & 1) * 32 + (swz % 64) / 2; }
__host__ __device__ __forceinline__ int perm32(int rho) { const int n = rho >> 4, i = rho & 15; return 8 * (i >> 2) + 4 * n + (i & 3); }

struct Unit { int pm, pn; };
struct Gemm { const bf16_t* A; const bf16_t* Bt; int M, N, K; };

struct StaticOrder {
    int nM, nN, nwg, G, c;
    __host__ __device__ void init(int M, int N, int G_, int c_) { nM = M / BM; nN = N / BM; nwg = nM * nN; G = G_; c = c_; }
    __host__ __device__ __forceinline__ bool next(int i, Unit& u) const {
        const long L = (long)i * G + c; if (L >= nwg) return false;
        int wgid = (int)L; { const int q = nwg / NXCD, r = nwg % NXCD, xcd = wgid % NXCD, off = wgid / NXCD; wgid = (xcd < r ? xcd * (q + 1) : r * (q + 1) + (xcd - r) * q) + off; }
        const int nig = WGM * nN, gid = wgid / nig, fm = gid * WGM, gsz = (nM - fm) < WGM ? (nM - fm) : WGM;
        u.pm = fm + ((wgid % nig) % gsz); u.pn = (wgid % nig) / gsz; return true;
    }
    __device__ __forceinline__ void a_ready(const Unit&) const {}
    __device__ __forceinline__ void done(const Unit&) const {}
};

__device__ __forceinline__ unsigned cvt_pk_bf16(float lo, float hi) { unsigned r; asm volatile("v_cvt_pk_bf16_f32 %0, %1, %2" : "=v"(r) : "v"(lo), "v"(hi)); return r; }
template <class Epi, class Sched, bool ALIGN_EPI = false, bool SP2 = false>
__device__ __forceinline__ void gemm_phase(PG8_LAS unsigned char* lds, const Gemm g, const Sched& S, const Epi& E) {
    const int tid = threadIdx.x, wid = __builtin_amdgcn_readfirstlane(tid >> 6), lane = tid & 63, wr = wid >> 2, wc = wid & 3, fr = lane & 15, fq = lane >> 4;
    const int K = g.K, nt = K / BK;
    unsigned voffA[2], voffB[2];
#pragma unroll
    for (int i = 0; i < 2; ++i) { int R, C; stage_rc(tid * 16 + i * 8192, R, C); const int Rb = Epi::PERM ? ((R & ~31) + perm32(R & 31)) : R;
        voffA[i] = (unsigned)(R * K + C) * 2u; voffB[i] = (unsigned)(Rb * K + C) * 2u; }
    const size_t kstep = (size_t)(BK * 2);
    const size_t hstep = (size_t)HALF * K * 2;
    const size_t tstep = 2 * hstep;
    const unsigned ldsw = (unsigned)wid * 1024u;
    const int aoff = lds_byte(wr * 64 + fr, fq * 8), boff = lds_byte(wc * 32 + fr, fq * 8);
#define PG8_SA(b, h) (((b) * 2 + (h)) * HTB)
#define PG8_SB(b, h) ((4 + (b) * 2 + (h)) * HTB)
#define PG8_STAGE(bufoff, gbase, voff) do { _Pragma("unroll") for (int _i = 0; _i < 2; ++_i) \
        __builtin_amdgcn_global_load_lds((const unsigned*)((const char*)(gbase) + (voff)[_i]), (PG8_LAS unsigned*)(lds + (bufoff) + ldsw + _i * 8192), 16, 0, 0); } while (0)
#define PG8_LDA(dst, b, h) do { _Pragma("unroll") for (int m = 0; m < 4; ++m) _Pragma("unroll") for (int k = 0; k < 2; ++k) dst[m][k] = *(const PG8_LAS bf16x8*)(lds + PG8_SA(b, h) + aoff + m * 2048 + k * 1024); } while (0)
#define PG8_LDB(dst, b, h) do { _Pragma("unroll") for (int n = 0; n < 2; ++n) _Pragma("unroll") for (int k = 0; k < 2; ++k) dst[n][k] = *(const PG8_LAS bf16x8*)(lds + PG8_SB(b, h) + boff + n * 2048 + k * 1024); } while (0)
#define PG8_MMA(ai, bj, At, Bt) do { __builtin_amdgcn_s_setprio(1); _Pragma("unroll") for (int m = 0; m < 4; ++m) _Pragma("unroll") for (int n = 0; n < 2; ++n) _Pragma("unroll") for (int k = 0; k < 2; ++k) \
        acc[ai][bj][m][n] = __builtin_amdgcn_mfma_f32_16x16x32_bf16(Bt[n][k], At[m][k], acc[ai][bj][m][n], 0, 0, 0); __builtin_amdgcn_s_setprio(0); } while (0)
#define PG8_WAIT_V(n) asm volatile("s_waitcnt vmcnt(" #n ")" ::: "memory")
#define PG8_WAIT_L(n) asm volatile("s_waitcnt lgkmcnt(" #n ")" ::: "memory")
#define PG8_BAR __builtin_amdgcn_s_barrier()
#define PG8_SCHED __builtin_amdgcn_sched_barrier(0)
    Unit cur, nxt; int ui = 0;
    if (!S.next(0, cur)) return;
    f32x4 acc[2][2][4][2];
#pragma unroll
    for (int a = 0; a < 2; ++a)
#pragma unroll
        for (int b = 0; b < 2; ++b)
#pragma unroll
            for (int m = 0; m < 4; ++m)
#pragma unroll
                for (int n = 0; n < 2; ++n) acc[a][b][m][n] = (f32x4){0.f, 0.f, 0.f, 0.f};
    bf16x8 At[4][2], B0[2][2], B1[2][2];
    const char* cA = (const char*)g.A + (size_t)cur.pm * tstep; const char* cB = (const char*)g.Bt + (size_t)cur.pn * tstep;
    S.a_ready(cur);
    if constexpr (SP2) {
        PG8_STAGE(PG8_SB(0, 0), cB, voffB); PG8_STAGE(PG8_SB(0, 1), cB + hstep, voffB); PG8_STAGE(PG8_SA(0, 0), cA, voffA); PG8_STAGE(PG8_SA(0, 1), cA + hstep, voffA);
        if (wr == 1) PG8_BAR;
        PG8_WAIT_V(2); PG8_BAR;
        PG8_STAGE(PG8_SB(1, 0), cB + kstep, voffB); PG8_STAGE(PG8_SA(1, 0), cA + kstep, voffA); PG8_STAGE(PG8_SB(1, 1), cB + hstep + kstep, voffB);
        PG8_WAIT_V(6); PG8_BAR;
    } else {
        PG8_STAGE(PG8_SB(0, 0), cB, voffB); PG8_STAGE(PG8_SA(0, 0), cA, voffA); PG8_STAGE(PG8_SB(0, 1), cB + hstep, voffB); PG8_STAGE(PG8_SA(0, 1), cA + hstep, voffA);
        if (wr == 1) PG8_BAR;
        PG8_WAIT_V(4); PG8_BAR;
        PG8_STAGE(PG8_SB(1, 0), cB + kstep, voffB); PG8_STAGE(PG8_SA(1, 0), cA + kstep, voffA); PG8_STAGE(PG8_SB(1, 1), cB + hstep + kstep, voffB);
        PG8_WAIT_V(6); PG8_BAR;
    }
    for (;;) {
        const bool has_next = S.next(ui + 1, nxt);
        const char* nA = has_next ? (const char*)g.A + (size_t)nxt.pm * tstep : cA; const char* nB = has_next ? (const char*)g.Bt + (size_t)nxt.pn * tstep : cB;
        for (int t = 0; t < nt; t += 2) {
            const bool last = (t == nt - 2);
            const char* a1 = cA + (size_t)(t + 1) * kstep;
            const char* a2 = last ? nA : cA + (size_t)(t + 2) * kstep; const char* b2 = last ? nB : cB + (size_t)(t + 2) * kstep;
            const char* a3 = a2 + kstep; const char* b3 = b2 + kstep;
            if (last && has_next) S.a_ready(nxt);
            if constexpr (SP2) {
            PG8_LDB(B0, 0, 0); PG8_LDB(B1, 0, 1); PG8_SCHED; PG8_LDA(At, 0, 0); PG8_STAGE(PG8_SA(1, 1), a1 + hstep, voffA);
            PG8_WAIT_V(8); PG8_WAIT_L(0); PG8_BAR; PG8_MMA(0, 0, At, B0); PG8_MMA(0, 1, At, B1); PG8_BAR; PG8_SCHED;
            PG8_LDA(At, 0, 1); PG8_STAGE(PG8_SB(0, 0), b2, voffB); PG8_STAGE(PG8_SB(0, 1), b2 + hstep, voffB); PG8_STAGE(PG8_SA(0, 0), a2, voffA);
            PG8_WAIT_V(8); PG8_WAIT_L(0); PG8_BAR; PG8_MMA(1, 0, At, B0); PG8_MMA(1, 1, At, B1); PG8_BAR; PG8_SCHED;
            PG8_LDB(B0, 1, 0); PG8_LDB(B1, 1, 1); PG8_SCHED; PG8_LDA(At, 1, 0); PG8_STAGE(PG8_SA(0, 1), a2 + hstep, voffA);
            PG8_WAIT_V(8); PG8_WAIT_L(0); PG8_BAR; PG8_MMA(0, 0, At, B0); PG8_MMA(0, 1, At, B1); PG8_BAR; PG8_SCHED;
            PG8_LDA(At, 1, 1); PG8_STAGE(PG8_SB(1, 0), b3, voffB); PG8_STAGE(PG8_SB(1, 1), b3 + hstep, voffB); PG8_STAGE(PG8_SA(1, 0), a3, voffA);
            PG8_WAIT_V(8); PG8_WAIT_L(0); PG8_BAR; PG8_MMA(1, 0, At, B0); PG8_MMA(1, 1, At, B1); PG8_BAR; PG8_SCHED;
            } else {
            PG8_LDB(B0, 0, 0); PG8_SCHED; PG8_LDA(At, 0, 0); PG8_STAGE(PG8_SA(1, 1), a1 + hstep, voffA);
            PG8_WAIT_L(8); PG8_BAR; PG8_WAIT_L(0); PG8_MMA(0, 0, At, B0); PG8_BAR; PG8_SCHED;
            PG8_LDB(B1, 0, 1); PG8_STAGE(PG8_SB(0, 0), b2, voffB);
            PG8_BAR; PG8_WAIT_L(0); PG8_MMA(0, 1, At, B1); PG8_BAR;
            PG8_LDA(At, 0, 1); PG8_STAGE(PG8_SA(0, 0), a2, voffA);
            PG8_BAR; PG8_WAIT_L(0); PG8_MMA(1, 0, At, B0); PG8_BAR; PG8_SCHED;
            PG8_STAGE(PG8_SB(0, 1), b2 + hstep, voffB);
            PG8_WAIT_V(6); PG8_BAR; PG8_MMA(1, 1, At, B1); PG8_BAR;
            PG8_LDB(B0, 1, 0); PG8_SCHED; PG8_LDA(At, 1, 0); PG8_STAGE(PG8_SA(0, 1), a2 + hstep, voffA);
            PG8_WAIT_L(8); PG8_BAR; PG8_WAIT_L(0); PG8_MMA(0, 0, At, B0); PG8_BAR; PG8_SCHED;
            PG8_LDB(B1, 1, 1); PG8_STAGE(PG8_SB(1, 0), b3, voffB);
            PG8_BAR; PG8_WAIT_L(0); PG8_MMA(0, 1, At, B1); PG8_BAR;
            PG8_LDA(At, 1, 1); PG8_STAGE(PG8_SA(1, 0), a3, voffA);
            PG8_BAR; PG8_WAIT_L(0); PG8_MMA(1, 0, At, B0); PG8_BAR; PG8_SCHED;
            PG8_STAGE(PG8_SB(1, 1), b3 + hstep, voffB);
            PG8_WAIT_V(6); PG8_BAR; PG8_MMA(1, 1, At, B1); PG8_BAR;
            }
        }
        if constexpr (ALIGN_EPI) { if (wr == 0) PG8_BAR; }
        if constexpr (!Epi::AFTER_DRAIN) { E(acc, cur, wr, wc, fr, fq); S.done(cur); }
        if (!has_next) break;
#pragma unroll
        for (int a = 0; a < 2; ++a)
#pragma unroll
            for (int b = 0; b < 2; ++b)
#pragma unroll
                for (int m = 0; m < 4; ++m)
#pragma unroll
                    for (int n = 0; n < 2; ++n) acc[a][b][m][n] = (f32x4){0.f, 0.f, 0.f, 0.f};
        cur = nxt; cA = nA; cB = nB; ++ui;
        if constexpr (ALIGN_EPI) { if (wr == 1) PG8_BAR; }
    }
    PG8_WAIT_V(0);
    if constexpr (!ALIGN_EPI) { if (wr == 0) PG8_BAR; }
    PG8_BAR;
    if constexpr (Epi::AFTER_DRAIN) { E.fused(acc, cur, wr, wc, fr, fq, lds, wid, lane); S.done(cur); }
#undef PG8_SA
#undef PG8_SB
#undef PG8_STAGE
#undef PG8_LDA
#undef PG8_LDB
#undef PG8_MMA
#undef PG8_WAIT_V
#undef PG8_WAIT_L
#undef PG8_BAR
#undef PG8_SCHED
}
}
namespace pg8 {
struct EpiBf16SS {
    static constexpr bool PERM = true, AFTER_DRAIN = false;
    bf16_t* O; int ldc; float* SS; int ssld; unsigned ssmask; int pnmask;
    const PG8_LAS float* rowscale; mutable int ord;
    __device__ __forceinline__ void operator()(const f32x4 (&acc)[2][2][4][2], const Unit& u, int wr, int wc, int fr, int fq) const {
        const int row0 = u.pm * BM + wr * 64 + fr, col0 = (u.pn & pnmask) * BM + wc * 32 + 8 * fq;
        const bool doss = ((ssmask >> u.pn) & 1u) != 0u;
#pragma unroll
        for (int ai = 0; ai < 2; ++ai)
#pragma unroll
            for (int m = 0; m < 4; ++m) { const int row = row0 + ai * HALF + m * 16; bf16_t* rowp = O + (size_t)row * ldc + col0;
#pragma unroll
                for (int bj = 0; bj < 2; ++bj) { f32x4 v0 = acc[ai][bj][m][0], v1 = acc[ai][bj][m][1];
                    if (rowscale) { const float rsc = rowscale[ord * BM + wr * 64 + fr + ai * HALF + m * 16]; v0 = v0 * rsc; v1 = v1 * rsc; }
                    u32x4 w; w.x = cvt_pk_bf16(v0[0], v0[1]); w.y = cvt_pk_bf16(v0[2], v0[3]); w.z = cvt_pk_bf16(v1[0], v1[1]); w.w = cvt_pk_bf16(v1[2], v1[3]);
                    *(u32x4*)(rowp + bj * HALF) = w;
                    if (doss) { float s = (v0[0] * v0[0] + v0[1] * v0[1]) + (v0[2] * v0[2] + v0[3] * v0[3]) + (v1[0] * v1[0] + v1[1] * v1[1]) + (v1[2] * v1[2] + v1[3] * v1[3]);
                        s += __shfl_xor(s, 16); s += __shfl_xor(s, 32);
                        if (fq == 0) SS[(size_t)row * ssld + ((u.pn * BM + bj * HALF + wc * 32) >> 5)] = s; } } }
        ++ord;
    }
};
struct EpiResF32 {
    static constexpr bool PERM = false, AFTER_DRAIN = false;
    const float* base; float* out; int ldc;
    __device__ __forceinline__ void operator()(const f32x4 (&acc)[2][2][4][2], const Unit& u, int wr, int wc, int fr, int fq) const {
        const int col0 = u.pn * BM + wc * 32 + 4 * fq;
#pragma unroll
        for (int ai = 0; ai < 2; ++ai)
#pragma unroll
            for (int m = 0; m < 4; ++m) { const size_t off = (size_t)(u.pm * BM + ai * HALF + wr * 64 + m * 16 + fr) * ldc + col0;
#pragma unroll
                for (int bj = 0; bj < 2; ++bj)
#pragma unroll
                    for (int n = 0; n < 2; ++n) { const f32x4 bs = *(const f32x4*)(base + off + bj * HALF + n * 16); *(f32x4*)(out + off + bj * HALF + n * 16) = bs + acc[ai][bj][m][n]; }
                if (m & 1) asm volatile("" ::: "memory"); }
    }
};
struct EpiResBf16 {
    static constexpr bool PERM = true, AFTER_DRAIN = false;
    const float* basef; const bf16_t* baseh; bf16_t* O; int ldc; float* SS; int ssld;
    __device__ __forceinline__ void operator()(const f32x4 (&acc)[2][2][4][2], const Unit& u, int wr, int wc, int fr, int fq) const {
        const int row0 = u.pm * BM + wr * 64 + fr, col0 = u.pn * BM + wc * 32 + 8 * fq;
#pragma unroll
        for (int ai = 0; ai < 2; ++ai)
#pragma unroll
            for (int m = 0; m < 4; ++m) { const int row = row0 + ai * HALF + m * 16; const size_t off = (size_t)row * ldc + col0;
#pragma unroll
                for (int bj = 0; bj < 2; ++bj) { f32x4 v0 = acc[ai][bj][m][0], v1 = acc[ai][bj][m][1];
                    if (basef) { v0 = v0 + *(const f32x4*)(basef + off + bj * HALF); v1 = v1 + *(const f32x4*)(basef + off + bj * HALF + 4); }
                    else { const u32x4 b = *(const u32x4*)(baseh + off + bj * HALF);
                        v0 = v0 + (f32x4){__uint_as_float(b.x << 16), __uint_as_float(b.x & 0xffff0000u), __uint_as_float(b.y << 16), __uint_as_float(b.y & 0xffff0000u)};
                        v1 = v1 + (f32x4){__uint_as_float(b.z << 16), __uint_as_float(b.z & 0xffff0000u), __uint_as_float(b.w << 16), __uint_as_float(b.w & 0xffff0000u)}; }
                    u32x4 w; w.x = cvt_pk_bf16(v0[0], v0[1]); w.y = cvt_pk_bf16(v0[2], v0[3]); w.z = cvt_pk_bf16(v1[0], v1[1]); w.w = cvt_pk_bf16(v1[2], v1[3]);
                    *(u32x4*)(O + off + bj * HALF) = w;
                    if (SS) { float s = (v0[0] * v0[0] + v0[1] * v0[1]) + (v0[2] * v0[2] + v0[3] * v0[3]) + (v1[0] * v1[0] + v1[1] * v1[1]) + (v1[2] * v1[2] + v1[3] * v1[3]);
                        s += __shfl_xor(s, 16); s += __shfl_xor(s, 32);
                        if (fq == 0) SS[(size_t)row * ssld + ((u.pn * BM + bj * HALF + wc * 32) >> 5)] = s; } }
                if (m & 1) asm volatile("" ::: "memory"); }
    }
};
struct EpiMoe1 {
    static constexpr bool PERM = true, AFTER_DRAIN = false;
    bf16_t* ACT; int ldc;
    __device__ __forceinline__ void operator()(const f32x4 (&acc)[2][2][4][2], const Unit& u, int wr, int wc, int fr, int fq) const {
        const int row0 = u.pm * BM + wr * 64 + fr, col0 = (u.pn & 3) * HALF + wc * 32 + 8 * fq;
#pragma unroll
        for (int ai = 0; ai < 2; ++ai)
#pragma unroll
            for (int m = 0; m < 4; ++m) { float a[8];
#pragma unroll
                for (int n = 0; n < 2; ++n)
#pragma unroll
                    for (int e = 0; e < 4; ++e) { const float g = acc[ai][0][m][n][e], up = acc[ai][1][m][n][e]; a[n * 4 + e] = g * __builtin_amdgcn_rcpf(1.0f + __expf(-g)) * up; }
                u32x4 w; w.x = cvt_pk_bf16(a[0], a[1]); w.y = cvt_pk_bf16(a[2], a[3]); w.z = cvt_pk_bf16(a[4], a[5]); w.w = cvt_pk_bf16(a[6], a[7]);
                *(u32x4*)(ACT + (size_t)(row0 + ai * HALF + m * 16) * ldc + col0) = w; }
    }
};
struct EpiMoe2 {
    static constexpr bool PERM = false, AFTER_DRAIN = false;
    float* out; int ldc; const int* slot_tok; const float* slot_w; const int* seg;
    __device__ __forceinline__ void operator()(const f32x4 (&acc)[2][2][4][2], const Unit& u, int wr, int wc, int fr, int fq) const {
        const int e = u.pn >> 2, send = seg[2 * e] + seg[2 * e + 1];
        const int col0 = (u.pn & 3) * BM + wc * 32 + 4 * fq;
#pragma unroll
        for (int ai = 0; ai < 2; ++ai)
#pragma unroll
            for (int m = 0; m < 4; ++m) { const int slot = u.pm * BM + ai * HALF + wr * 64 + m * 16 + fr;
                if (slot < send) { const int tok = slot_tok[slot]; const float w = slot_w[slot]; float* op = out + (size_t)tok * ldc + col0;
#pragma unroll
                    for (int bj = 0; bj < 2; ++bj)
#pragma unroll
                        for (int n = 0; n < 2; ++n)
#pragma unroll
                            for (int q = 0; q < 4; ++q) unsafeAtomicAdd(op + bj * HALF + n * 16 + q, w * acc[ai][bj][m][n][q]); } }
    }
};
struct MoeOrder {
    int ntile, G, c; const PG8_LAS int* tile_e;
    __device__ __forceinline__ bool next(int i, Unit& u) const {
        const int L = i * G + c; if (L >= ntile * 4) return false;
        const int ti = L >> 2; u.pm = ti; u.pn = __builtin_amdgcn_readfirstlane(tile_e[ti]) * 4 + (L & 3); return true;
    }
    __device__ __forceinline__ void a_ready(const Unit&) const {}
    __device__ __forceinline__ void done(const Unit&) const {}
};
}
namespace att {
#define ALAS __attribute__((address_space(3)))
typedef unsigned short bf16_t;
typedef short bf16x8 __attribute__((ext_vector_type(8)));
typedef short s16x4 __attribute__((ext_vector_type(4)));
typedef float f32x16 __attribute__((ext_vector_type(16)));
typedef float f32x4 __attribute__((ext_vector_type(4)));
typedef unsigned u32x4 __attribute__((ext_vector_type(4)));
enum { FOX = 0, DIFF = 1, CROSS = 2 };
constexpr int SUBT = 16384;
constexpr float LOG2E = 1.4426950408889634f, NEPS = 1e-6f, THR = 8.f;
constexpr int SEQ = 2048, PROJW = 3072, DM = 1024, NMEM = 256;
constexpr int BT_N = 320, BT_OFF = 224;

template <int T> struct AC;
template <> struct AC<FOX>   { static constexpr int NKS = 8,  ROWS = 256, KSUB = 1, VSUB = 1; };
template <> struct AC<DIFF>  { static constexpr int NKS = 4,  ROWS = 128, KSUB = 1, VSUB = 1; };
template <> struct AC<CROSS> { static constexpr int NKS = 16, ROWS = 128, KSUB = 2, VSUB = 2; };

__device__ __forceinline__ int kswz(int row, int colB) { return row * 256 + (colB ^ ((row & 7) << 4)); }
__device__ __forceinline__ int v_st(int k, int c) { const int kk = (k & ~0xC) | ((k & 4) << 1) | ((k & 8) >> 1); return ((kk >> 3) * 4 + (c >> 5)) * 512 + ((kk & 7) * 32 + (c & 31)) * 2; }
__device__ __forceinline__ int v_rd_base(int lane) { return ((lane & 3) << 3) | (((lane >> 2) & 3) << 6) | (((lane >> 4) & 1) << 5) | (((lane >> 5) & 1) << 8); }
__device__ __forceinline__ int crow(int r, int hi) { return (r & 3) + 8 * (r >> 2) + 4 * hi; }
__device__ __forceinline__ unsigned cvtpk(float lo, float hi) { unsigned r; asm volatile("v_cvt_pk_bf16_f32 %0, %1, %2" : "=v"(r) : "v"(lo), "v"(hi)); return r; }
__device__ __forceinline__ float bflo(unsigned w) { return __uint_as_float(w << 16); }
__device__ __forceinline__ float bfhi(unsigned w) { return __uint_as_float(w & 0xffff0000u); }
#define ASBAR() __builtin_amdgcn_sched_barrier(0)

__device__ __forceinline__ bf16x8 qprep(u32x4 raw, float s, const ALAS float* G) {
    const f32x4 g0 = *(const ALAS f32x4*)G, g1 = *(const ALAS f32x4*)(G + 4);
    u32x4 w;
    w.x = cvtpk(bflo(raw.x) * s * g0[0], bfhi(raw.x) * s * g0[1]); w.y = cvtpk(bflo(raw.y) * s * g0[2], bfhi(raw.y) * s * g0[3]);
    w.z = cvtpk(bflo(raw.z) * s * g1[0], bfhi(raw.z) * s * g1[1]); w.w = cvtpk(bflo(raw.w) * s * g1[2], bfhi(raw.w) * s * g1[3]);
    return __builtin_bit_cast(bf16x8, w);
}

struct Ptrs {
    const bf16_t* PROJ;  const float* SS;
    const float* NEGC;
    const bf16_t* QC;    const float* SSQC;
    const bf16_t* KVC;   const float* SSKV;
    bf16_t* MIX;         bf16_t* CO;
    const float* g_fox_out; const float* g_subln;
    float lam, one_m_lam_init;
};

template <int T> constexpr int tilesz() { return (AC<T>::KSUB + AC<T>::VSUB) * SUBT; }
constexpr int KT_OFF_SELF = 65536, KT_OFF_CROSS = 131072;
__device__ __forceinline__ void dma16(const void* g, ALAS unsigned char* l) { __builtin_amdgcn_global_load_lds((const unsigned*)g, (ALAS unsigned*)l, 16, 0, 0); }
template <int T>
__device__ __forceinline__ void attn_unit(const Ptrs& P, int b, int h, int blk, ALAS unsigned char* lds, ALAS float* wsf, const ALAS float* GQ, const ALAS float* BT) {
    constexpr int NKS = AC<T>::NKS, ROWS = AC<T>::ROWS, KSUB = AC<T>::KSUB, VSUB = AC<T>::VSUB, BUFSZ = tilesz<T>();
    constexpr int KT_OFF = (T == CROSS) ? KT_OFF_CROSS : KT_OFF_SELF, STG_OFF = (T == CROSS) ? 0 : 65536;
    int tid_ = threadIdx.x; asm volatile("" : "+v"(tid_));
    const int tid = tid_, wid = __builtin_amdgcn_readfirstlane(tid >> 6), lane = tid & 63, r32 = lane & 31, hi = lane >> 5;
    const int rg = (T == FOX) ? wid : (wid & 3), sel = (T == FOX) ? 0 : (wid >> 2);
    const int P0 = blk * ROWS, qlo = P0 + 32 * rg;
    const int NT = (T == CROSS) ? NMEM / 64 : (P0 + ROWS) / 64;
    const bf16_t* Kp; const bf16_t* Vp; int kvpitch; const float* SSk; int sskld;
    if constexpr (T == FOX)  { Kp = P.PROJ + (size_t)b * SEQ * PROJW + 2048 + h * 128; Vp = Kp + 512; kvpitch = PROJW; SSk = P.SS + (size_t)b * SEQ * 96 + 64 + 4 * h; sskld = 96; }
    if constexpr (T == DIFF) { Kp = P.PROJ + (size_t)b * SEQ * PROJW + 512 + h * 128;  Vp = Kp + 512; kvpitch = PROJW; SSk = P.SS + (size_t)b * SEQ * 96 + 16 + 4 * h; sskld = 96; }
    if constexpr (T == CROSS){ Kp = P.KVC + (size_t)b * NMEM * 2048 + h * 256;         Vp = Kp + 1024; kvpitch = 2048; SSk = P.SSKV + (size_t)b * NMEM * 64 + 8 * h; sskld = 64; }
    ALAS float* KT = (ALAS float*)(lds + KT_OFF);
    for (int k = tid; k < NT * 64; k += 512) {
        const f32x4 s4 = *(const f32x4*)(SSk + (size_t)k * sskld);
        if constexpr (T == FOX)   { KT[k] = __builtin_amdgcn_rsqf(((s4[0] + s4[1]) + (s4[2] + s4[3])) * (1.f / 128.f) + NEPS); KT[2048 + k] = P.NEGC[(size_t)(b * 4 + h) * SEQ + k]; }
        if constexpr (T == DIFF)  { KT[k] = __builtin_amdgcn_rsqf((s4[0] + s4[1]) * (1.f / 64.f) + NEPS); KT[2048 + k] = __builtin_amdgcn_rsqf((s4[2] + s4[3]) * (1.f / 64.f) + NEPS); }
        if constexpr (T == CROSS) { const f32x4 s5 = *(const f32x4*)(SSk + (size_t)k * sskld + 4); KT[k] = __builtin_amdgcn_rsqf((((s4[0] + s4[1]) + (s4[2] + s4[3])) + ((s5[0] + s5[1]) + (s5[2] + s5[3]))) * (1.f / 256.f) + NEPS); }
    }
    int koff[2], voff[2];
#pragma unroll
    for (int i = 0; i < 2; ++i) { const int pi = 2 * wid + i;
        { const int row = pi * 4 + (lane >> 4), lc = (lane & 15) ^ (row & 7); koff[i] = row * kvpitch + lc * 8; }
        { const int st = pi * 2 + (lane >> 5), kk = (st >> 2) * 8 + ((lane >> 2) & 7), c = (st & 3) * 32 + (lane & 3) * 8;
          const int k = (kk & ~0xC) | ((kk & 4) << 1) | ((kk & 8) >> 1); voff[i] = k * kvpitch + c; } }
#define A_DMA(t, bf) do { const size_t to_ = (size_t)(t) * 64 * kvpitch; ALAS unsigned char* d_ = lds + (bf) * BUFSZ + wid * 2048; \
        _Pragma("unroll") for (int s_ = 0; s_ < KSUB; ++s_) { dma16(Kp + to_ + s_ * 128 + koff[0], d_ + s_ * SUBT); dma16(Kp + to_ + s_ * 128 + koff[1], d_ + s_ * SUBT + 1024); } \
        _Pragma("unroll") for (int s_ = 0; s_ < VSUB; ++s_) { dma16(Vp + to_ + s_ * 128 + voff[0], d_ + (KSUB + s_) * SUBT); dma16(Vp + to_ + s_ * 128 + voff[1], d_ + (KSUB + s_) * SUBT + 1024); } } while (0)
    A_DMA(0, 0);
    bf16x8 qr[NKS];
    {
        const int qrow = qlo + r32; float ssq; const bf16_t* qp;
        const size_t tok = (size_t)b * SEQ + qrow;
        if constexpr (T == FOX)  { const f32x4 s4 = *(const f32x4*)(P.SS + tok * 96 + 48 + 4 * h); ssq = ((s4[0] + s4[1]) + (s4[2] + s4[3])) * (1.f / 128.f); qp = P.PROJ + tok * PROJW + 1536 + h * 128; }
        if constexpr (T == DIFF) { const float* sp = P.SS + tok * 96 + 4 * h + 2 * sel; ssq = (sp[0] + sp[1]) * (1.f / 64.f); qp = P.PROJ + tok * PROJW + h * 128 + sel * 64; }
        if constexpr (T == CROSS){ const f32x4 s4 = *(const f32x4*)(P.SSQC + tok * 32 + 8 * h), s5 = *(const f32x4*)(P.SSQC + tok * 32 + 8 * h + 4);
                                   ssq = (((s4[0] + s4[1]) + (s4[2] + s4[3])) + ((s5[0] + s5[1]) + (s5[2] + s5[3]))) * (1.f / 256.f); qp = P.QC + tok * DM + h * 256; }
        const float rq = __builtin_amdgcn_rsqf(ssq + NEPS);
#pragma unroll
        for (int ks = 0; ks < NKS; ++ks) { const u32x4 raw = *(const u32x4*)(qp + ks * 16 + hi * 8); qr[ks] = qprep(raw, rq, GQ + ks * 16 + hi * 8); }
    }
    float m_reg = -1e30f, l_reg = 0.f; f32x16 o[4];
#pragma unroll
    for (int d = 0; d < 4; ++d) o[d] = f32x16{};
    const int vbl = v_rd_base(lane);
    for (int t = 0; t < NT; ++t) {
        const int cur = t & 1, kb = t * 64;
        asm volatile("s_waitcnt vmcnt(0)" ::: "memory");
        __syncthreads();
        if (t + 1 < NT) A_DMA(t + 1, cur ^ 1);
        ALAS unsigned char* tb = lds + cur * BUFSZ;
        bool act;
        if constexpr (T == FOX)  act = (kb <= qlo + 31);
        if constexpr (T == DIFF) act = (t <= (qlo >> 6));
        if constexpr (T == CROSS) act = true;
        if (act) {
            f32x16 p0 = f32x16{}, p1 = f32x16{};
            {
                const ALAS unsigned char* kt = tb + ((T == DIFF) ? sel * 128 : 0);
#pragma unroll
                for (int ks = 0; ks < NKS; ++ks) {
                    const int sub = ks >> 3, dd = ks & 7;
                    const ALAS unsigned char* a = kt + sub * SUBT + kswz(r32, ((dd & 3) * 16 + hi * 8) * 2) + (dd >> 2) * 128;
                    const bf16x8 b0 = *(const ALAS bf16x8*)a, b1 = *(const ALAS bf16x8*)(a + 32 * 256);
                    p0 = __builtin_amdgcn_mfma_f32_32x32x16_bf16(b0, qr[ks], p0, 0, 0, 0);
                    p1 = __builtin_amdgcn_mfma_f32_32x32x16_bf16(b1, qr[ks], p1, 0, 0, 0);
                }
            }
            {
                const ALAS float* rkp = KT + ((T == DIFF) ? sel * 2048 : 0) + kb + 4 * hi;
                const bool near = (T == DIFF) ? (kb + 63 - qlo > -128) : false;
                const ALAS float* btp = BT + (kb - qlo + BT_OFF + 4 * hi - r32);
                const float bfar = (T == DIFF) ? BT[0] : 0.f;
#pragma unroll
                for (int g = 0; g < 4; ++g) {
                    const f32x4 rk0 = *(const ALAS f32x4*)(rkp + 8 * g), rk1 = *(const ALAS f32x4*)(rkp + 32 + 8 * g);
                    f32x4 a0 = {0.f, 0.f, 0.f, 0.f}, a1 = {0.f, 0.f, 0.f, 0.f};
                    if constexpr (T == FOX)  { a0 = *(const ALAS f32x4*)(rkp + 2048 + 8 * g); a1 = *(const ALAS f32x4*)(rkp + 2048 + 32 + 8 * g); }
                    if constexpr (T == DIFF) { if (near) { a0 = (f32x4){btp[8 * g], btp[8 * g + 1], btp[8 * g + 2], btp[8 * g + 3]}; a1 = (f32x4){btp[32 + 8 * g], btp[33 + 8 * g], btp[34 + 8 * g], btp[35 + 8 * g]}; }
                                               else { a0 = (f32x4){bfar, bfar, bfar, bfar}; a1 = a0; } }
#pragma unroll
                    for (int e = 0; e < 4; ++e) { p0[4 * g + e] = __builtin_fmaf(p0[4 * g + e], rk0[e], a0[e]); p1[4 * g + e] = __builtin_fmaf(p1[4 * g + e], rk1[e], a1[e]); }
                }
                if constexpr (T == FOX) {
                    if (kb + 63 > qlo) {
                        const float NEG = -__builtin_inff(); const int dq = qlo + r32 - kb - 4 * hi;
#pragma unroll
                        for (int r = 0; r < 16; ++r) { const int c = (r & 3) + 8 * (r >> 2); if (c > dq) p0[r] = NEG; if (c + 32 > dq) p1[r] = NEG; }
                    }
                }
            }
            float alpha;
            {
                float pmax = p0[0];
#pragma unroll
                for (int r = 1; r < 16; ++r) pmax = fmaxf(pmax, p0[r]);
#pragma unroll
                for (int r = 0; r < 16; ++r) pmax = fmaxf(pmax, p1[r]);
                { auto rr = __builtin_amdgcn_permlane32_swap(__float_as_uint(pmax), __float_as_uint(pmax), false, false); pmax = fmaxf(__uint_as_float(rr[0]), __uint_as_float(rr[1])); }
                if (__builtin_expect(__all(pmax - m_reg <= THR), 1)) { alpha = 1.f; }
                else { const float mn = fmaxf(m_reg, pmax); alpha = __builtin_amdgcn_exp2f(m_reg - mn); m_reg = mn; }
#pragma unroll
                for (int r = 0; r < 16; ++r) { p0[r] = __builtin_amdgcn_exp2f(p0[r] - m_reg); p1[r] = __builtin_amdgcn_exp2f(p1[r] - m_reg); }
                float ps = 0.f;
#pragma unroll
                for (int r = 0; r < 16; ++r) ps += p0[r] + p1[r];
                { auto rr = __builtin_amdgcn_permlane32_swap(__float_as_uint(ps), __float_as_uint(ps), false, false); ps = __uint_as_float(rr[0]) + __uint_as_float(rr[1]); }
                l_reg = l_reg * alpha + ps;
            }
            bf16x8 pa0, pa1, pa2, pa3;
#define A_PK4(Pv, B_, OUT) do { unsigned a0_ = cvtpk(Pv[B_ + 0], Pv[B_ + 1]), a1_ = cvtpk(Pv[B_ + 2], Pv[B_ + 3]), b0_ = cvtpk(Pv[B_ + 4], Pv[B_ + 5]), b1_ = cvtpk(Pv[B_ + 6], Pv[B_ + 7]); \
        auto r0_ = __builtin_amdgcn_permlane32_swap(a0_, b0_, false, false); auto r1_ = __builtin_amdgcn_permlane32_swap(a1_, b1_, false, false); \
        u32x4 w_ = {r0_[0], r1_[0], r0_[1], r1_[1]}; OUT = __builtin_bit_cast(bf16x8, w_); } while (0)
            A_PK4(p0, 0, pa0); A_PK4(p0, 8, pa1); A_PK4(p1, 0, pa2); A_PK4(p1, 8, pa3);
#undef A_PK4
            if (__any(alpha < 1.f)) {
                if (hi == 0) wsf[r32] = alpha;
                asm volatile("s_waitcnt lgkmcnt(0)" ::: "memory");
#pragma unroll
                for (int r = 0; r < 16; ++r) { const float al = wsf[crow(r, hi)];
#pragma unroll
                    for (int d = 0; d < 4; ++d) o[d][r] *= al; }
            }
            {
                const int vb0 = (int)(unsigned)(size_t)(tb + (KSUB + ((T == CROSS) ? sel : 0)) * SUBT) + vbl;
#define A_TRRD(dst, off) asm volatile("ds_read_b64_tr_b16 %0, %1 offset:%2" : "=&v"(dst) : "v"(vb0), "i"(off) : "memory")
#define A_PV(d0) do { s16x4 l0, l1, l2, l3, h0, h1, h2, h3; constexpr int b_ = (d0) * 512; \
        A_TRRD(l0, b_); A_TRRD(h0, b_ + 2048); A_TRRD(l1, b_ + 4096); A_TRRD(h1, b_ + 6144); A_TRRD(l2, b_ + 8192); A_TRRD(h2, b_ + 10240); A_TRRD(l3, b_ + 12288); A_TRRD(h3, b_ + 14336); \
        asm volatile("s_waitcnt lgkmcnt(0)" ::: "memory"); ASBAR(); \
        o[d0] = __builtin_amdgcn_mfma_f32_32x32x16_bf16(pa0, (bf16x8){l0[0], l0[1], l0[2], l0[3], h0[0], h0[1], h0[2], h0[3]}, o[d0], 0, 0, 0); \
        o[d0] = __builtin_amdgcn_mfma_f32_32x32x16_bf16(pa1, (bf16x8){l1[0], l1[1], l1[2], l1[3], h1[0], h1[1], h1[2], h1[3]}, o[d0], 0, 0, 0); \
        o[d0] = __builtin_amdgcn_mfma_f32_32x32x16_bf16(pa2, (bf16x8){l2[0], l2[1], l2[2], l2[3], h2[0], h2[1], h2[2], h2[3]}, o[d0], 0, 0, 0); \
        o[d0] = __builtin_amdgcn_mfma_f32_32x32x16_bf16(pa3, (bf16x8){l3[0], l3[1], l3[2], l3[3], h3[0], h3[1], h3[2], h3[3]}, o[d0], 0, 0, 0); } while (0)
                A_PV(0); A_PV(1); A_PV(2); A_PV(3);
#undef A_PV
#undef A_TRRD
            }
        }
    }
#undef A_DMA
    __syncthreads();
    if (hi == 0) wsf[32 + r32] = l_reg;
    asm volatile("s_waitcnt lgkmcnt(0)" ::: "memory");
#pragma unroll
    for (int r = 0; r < 16; ++r) { const float rl = __builtin_amdgcn_rcpf(wsf[32 + crow(r, hi)]);
#pragma unroll
        for (int d = 0; d < 4; ++d) o[d][r] *= rl; }
    if constexpr (T == DIFF) {
        ALAS float* hnd = (ALAS float*)lds + (size_t)rg * 4096 + lane;
        if (sel == 1) {
#pragma unroll
            for (int d = 0; d < 4; ++d)
#pragma unroll
                for (int r = 0; r < 16; ++r) hnd[(d * 16 + r) * 64] = o[d][r];
        }
        __syncthreads();
        if (sel == 0) {
#pragma unroll
            for (int d = 0; d < 4; ++d)
#pragma unroll
                for (int r = 0; r < 16; ++r) o[d][r] = o[d][r] - P.lam * hnd[(d * 16 + r) * 64];
        }
    }
    if (T == CROSS || sel == 0) {
        float gcol[4]; bf16_t* op;
        if constexpr (T == FOX)  { op = P.MIX + ((size_t)b * SEQ + qlo) * DM + 512 + h * 128;
#pragma unroll
            for (int d = 0; d < 4; ++d) gcol[d] = P.g_fox_out[32 * d + r32]; }
        if constexpr (T == DIFF) { op = P.MIX + ((size_t)b * SEQ + qlo) * DM + h * 128;
#pragma unroll
            for (int d = 0; d < 4; ++d) gcol[d] = P.g_subln[32 * d + r32] * P.one_m_lam_init; }
        if constexpr (T == CROSS){ op = P.CO + ((size_t)b * SEQ + qlo) * DM + h * 256 + sel * 128;
#pragma unroll
            for (int d = 0; d < 4; ++d) gcol[d] = 1.f; }
        ALAS bf16_t* stg = (ALAS bf16_t*)(lds + STG_OFF) + ((T == DIFF) ? rg : wid) * 4096;
#pragma unroll
        for (int r = 0; r < 16; ++r) {
            float rs = 1.f;
            if constexpr (T != CROSS) {
                float s = (o[0][r] * o[0][r] + o[1][r] * o[1][r]) + (o[2][r] * o[2][r] + o[3][r] * o[3][r]);
                s += __shfl_xor(s, 1); s += __shfl_xor(s, 2); s += __shfl_xor(s, 4); s += __shfl_xor(s, 8); s += __shfl_xor(s, 16);
                rs = __builtin_amdgcn_rsqf(s * (1.f / 128.f) + NEPS);
            }
            const int orow = crow(r, hi);
#pragma unroll
            for (int d = 0; d < 4; ++d) { const unsigned w = cvtpk(o[d][r] * rs * gcol[d], 0.f); stg[orow * 128 + 32 * d + r32] = (bf16_t)(w & 0xffffu); }
        }
        asm volatile("s_waitcnt lgkmcnt(0)" ::: "memory");
#pragma unroll
        for (int i = 0; i < 8; ++i) { const int row = i * 4 + (lane >> 4), ch = lane & 15; const u32x4 v = *(const ALAS u32x4*)(stg + row * 128 + ch * 8); *(u32x4*)(op + (size_t)row * DM + ch * 8) = v; }
    }
    __syncthreads();
}
#undef ASBAR
}
constexpr int NWAVES = 8, NTHR = NWAVES * 64;
constexpr int BATCH = 8, SEQ = 2048, DM = 1024, NTOK = BATCH * SEQ, NMEM = 256, MROWS = BATCH * NMEM;
constexpr int INCOLS = 3076, PROJW = 3072, NEXP = 16, DEXP = 512;
constexpr int SLOT_MAX = 2 * NTOK + NEXP * 256;
constexpr float EPS = 1e-6f, LOG2E = 1.4426950408889634f;
#ifndef MK_ONE_LAUNCH
#define MK_ONE_LAUNCH 1
#endif
#ifndef MK_PH_END
#define MK_PH_END 13
#endif
constexpr int N_PHASES = 13;
constexpr size_t MiB = 1u << 20, KiB = 1u << 10;
constexpr size_t WS_CTL = 0, CTL_ZERO_BYTES = 1 * MiB;
constexpr size_t WS_WIN = 2 * MiB, WS_WOUT = 8 * MiB, WS_WCQ = 10 * MiB, WS_WCKV = 12 * MiB, WS_WCO = 16 * MiB, WS_W1 = 18 * MiB, WS_W2 = 50 * MiB;
constexpr size_t WS_MEMN = 66 * MiB, WS_KVC = 70 * MiB, WS_SS = 78 * MiB, WS_H = 84 * MiB, WS_PROJ = 116 * MiB, WS_ACT = 204 * MiB, WS_SM = 248 * MiB, WS_END = 256 * MiB;
constexpr size_t WS_QC = WS_PROJ, WS_CO = WS_PROJ + 32 * MiB, WS_X1B = WS_PROJ + 64 * MiB;
constexpr size_t WS_X2B = 66 * MiB, WS_T = 98 * MiB, WS_TPERM = 130 * MiB, WS_Y = WS_TPERM, WS_SSX1 = WS_SS;
constexpr size_t WS_NEGC = WS_SM, WS_LOGF = WS_SM + 256 * KiB, WS_CHOICE = WS_SM + 512 * KiB, WS_SLOTTOK = WS_SM + 768 * KiB, WS_SLOTW = WS_SM + 928 * KiB,
                 WS_CHUNKCNT = WS_SM + 1088 * KiB, WS_MOESEG = WS_SM + 1104 * KiB, WS_TOKSLOT = WS_SM + 1152 * KiB, WS_SSKV = WS_SM + 2 * MiB, WS_SSQC = WS_SM + 3 * MiB;
static_assert(WS_TPERM + (size_t)SLOT_MAX * DM * 2 <= WS_ACT && WS_ACT + (size_t)SLOT_MAX * DEXP * 2 <= WS_SM && WS_SSQC + (size_t)NTOK * 32 * 4 <= WS_END && WS_X2B + 32 * MiB <= WS_T && WS_T + 32 * MiB <= WS_TPERM && WS_T + 32 * MiB <= WS_CO, "d_ws map");
constexpr int CW_TMO = 0, CW_QFOX = 64, CW_QDIFF = 128, CW_BAR = 4096;
constexpr int RING_BYTES = 133120;
constexpr int L_WSF = RING_BYTES, L_GQ = L_WSF + 2048, L_BT = L_GQ + 1024, L_MISC = L_BT + 4 * att::BT_N * 4, L_TILEE = L_MISC + 256, LDS_BYTES = 147456;
static_assert(RING_BYTES >= pg8::STAGE_BYTES && L_TILEE + 160 * 4 <= LDS_BYTES, "LDS map");

#define GAS __attribute__((address_space(1)))
#define LAS __attribute__((address_space(3)))
typedef unsigned short bf16;
typedef unsigned v4u __attribute__((ext_vector_type(4)));
typedef float f32x4 __attribute__((ext_vector_type(4)));
typedef short bf16x8 __attribute__((ext_vector_type(8)));
typedef GAS unsigned gu32;
typedef GAS unsigned long long gu64;
#define RLX_AGENT __ATOMIC_RELAXED, __HIP_MEMORY_SCOPE_AGENT
#define LDS_WAIT() asm volatile("s_waitcnt lgkmcnt(0)" ::: "memory")
#define VM_WAIT() asm volatile("s_waitcnt vmcnt(0)" ::: "memory")
__device__ __forceinline__ unsigned long long rt() { return __builtin_amdgcn_s_memrealtime(); }
__device__ __forceinline__ unsigned f2bf(float f) { unsigned u = __builtin_bit_cast(unsigned, f); return (u + 0x7fffu + ((u >> 16) & 1u)) >> 16; }
__device__ __forceinline__ unsigned pk2(float lo, float hi) { return f2bf(lo) | (f2bf(hi) << 16); }
#define XB_TMO      128
#define XB_XCNT(j)  (256  + 64 * (j))
#define XB_XSUB(j)  (1280 + 64 * (j))
#define XB_XGEN(j)  (2304 + 64 * (j))
#define XB_TOP      3328
#define XB_TOPGEN   3392
#define XCD_BAR_WORDS 3456
#define XB_SPIN_CAP (1u << 18)

__device__ __forceinline__ unsigned xb_ld(unsigned* p)              { return __hip_atomic_load(p, __ATOMIC_RELAXED, __HIP_MEMORY_SCOPE_AGENT); }
__device__ __forceinline__ unsigned xb_add(unsigned* p, unsigned v) { return __hip_atomic_fetch_add(p, v, __ATOMIC_RELAXED, __HIP_MEMORY_SCOPE_AGENT); }
__device__ __forceinline__ unsigned xb_xcc_id() { return (unsigned)__builtin_amdgcn_s_getreg((3 << 11) | 20) & 0xFu; }
#define XB_SPIN(cond, bar) do { unsigned _sp = 0; while (cond) { __builtin_amdgcn_s_sleep(1); \
    if ((++_sp & 255u) == 0u) { if (xb_ld(&(bar)[XB_TMO])) break; if (_sp > XB_SPIN_CAP) { atomicAdd(&(bar)[XB_TMO], 1u); break; } } } } while (0)

struct XcdBarrier {
    unsigned* bar; unsigned x;
    volatile LAS unsigned* st;
};

__device__ __forceinline__ XcdBarrier xcd_barrier_post(unsigned* bar, volatile LAS unsigned* st) {
    XcdBarrier b; b.bar = bar; b.x = xb_xcc_id(); b.st = st;
    if (threadIdx.x == 0) (void)xb_add(&bar[XB_XCNT(b.x)], 1u);
    return b;
}
__device__ __forceinline__ void xcd_barrier_complete(unsigned* bar, unsigned x, unsigned& nloc, unsigned& nx) {
    const unsigned G = gridDim.x * gridDim.y * gridDim.z;
    unsigned sum, cnt, mine, sp = 0u;
    for (;;) {
        sum = 0u; cnt = 0u; mine = 0u;
#pragma unroll
        for (unsigned j = 0; j < 16; ++j) { const unsigned c = xb_ld(&bar[XB_XCNT(j)]); sum += c; cnt += (c > 0u) ? 1u : 0u; mine = (j == x) ? c : mine; }
        if (sum == G) break;
        __builtin_amdgcn_s_sleep(1);
        if ((++sp & 255u) == 0u) { if (xb_ld(&bar[XB_TMO])) break; if (sp > XB_SPIN_CAP) { atomicAdd(&bar[XB_TMO], 1u); break; } }
    }
    nloc = mine > 0u ? mine : 1u; nx = cnt > 0u ? cnt : 1u;
}

__device__ __forceinline__ void xcd_barrier(const XcdBarrier& b) {
    asm volatile("s_waitcnt vmcnt(0)" ::: "memory");
    __syncthreads();
    if (threadIdx.x == 0) {
        unsigned* bar = b.bar;
        __builtin_amdgcn_s_waitcnt(0);
        unsigned nloc = b.st[0], nx = b.st[1];
        if (nloc == 0u) { xcd_barrier_complete(bar, b.x, nloc, nx); b.st[0] = nloc; b.st[1] = nx; }
        const unsigned old = xb_add(&bar[XB_XSUB(b.x)], 1u);
        const unsigned gen = old / nloc;
        if (old + 1u == (gen + 1u) * nloc) {
            __builtin_amdgcn_fence(__ATOMIC_RELEASE, "agent");
            asm volatile("s_waitcnt vmcnt(0)" ::: "memory");
            const unsigned og = xb_add(&bar[XB_TOP], 1u);
            const unsigned tg = og / nx;
            if (og + 1u == (tg + 1u) * nx) xb_add(&bar[XB_TOPGEN], 1u);
            else XB_SPIN(xb_ld(&bar[XB_TOPGEN]) == tg, bar);
            __builtin_amdgcn_fence(__ATOMIC_ACQUIRE, "agent");
            xb_add(&bar[XB_XGEN(b.x)], 1u);
            asm volatile("s_waitcnt vmcnt(0)" ::: "memory");
        } else {
            XB_SPIN(xb_ld(&bar[XB_XGEN(b.x)]) == gen, bar);
            __builtin_amdgcn_fence(__ATOMIC_ACQUIRE, "agent");
            asm volatile("s_waitcnt vmcnt(0)" ::: "memory");
        }
    }
    __syncthreads();
}

__device__ __forceinline__ float wave_sum(float v) {
#pragma unroll
    for (int o = 1; o < 64; o <<= 1) v += __shfl_xor(v, o);
    return v;
}
__device__ __forceinline__ void tr_item(const float* W, int ldw, int k0, int n0, bf16* WT, int drow0, int K, LAS float* scr, int lane, const float* kgain = nullptr) {
#pragma unroll 8
    for (int i = 0; i < 32; ++i) { const int kk = 2 * i + (lane >> 5); float w = W[(size_t)(k0 + kk) * ldw + n0 + (lane & 31)]; if (kgain) w *= kgain[k0 + kk]; scr[kk * 33 + (lane & 31)] = w; }
    LDS_WAIT(); asm volatile("" ::: "memory");
    const int c = lane & 7;
#pragma unroll
    for (int j = 0; j < 4; ++j) { const int n = (lane >> 3) + 8 * j; const LAS float* s = scr + (8 * c) * 33 + n;
        v4u o; o.x = pk2(s[0 * 33], s[1 * 33]); o.y = pk2(s[2 * 33], s[3 * 33]); o.z = pk2(s[4 * 33], s[5 * 33]); o.w = pk2(s[6 * 33], s[7 * 33]);
        *(GAS v4u*)(WT + (size_t)(drow0 + n) * K + k0 + 8 * c) = o; }
    LDS_WAIT(); asm volatile("" ::: "memory");
}
__device__ __forceinline__ float row_load_rstd(const float* xrow, int lane, f32x4 (&v)[4]) {
    const GAS f32x4* xr = (const GAS f32x4*)xrow + lane; float s = 0.f;
#pragma unroll
    for (int j = 0; j < 4; ++j) { v[j] = xr[64 * j]; s += (v[j].x * v[j].x + v[j].y * v[j].y) + (v[j].z * v[j].z + v[j].w * v[j].w); }
    return 1.0f / sqrtf(wave_sum(s) * (1.f / DM) + EPS);
}
__device__ __forceinline__ void row_store_bf16(bf16* orow, int lane, const f32x4 (&v)[4]) {
    GAS unsigned long long* o8 = (GAS unsigned long long*)orow + lane;
#pragma unroll
    for (int j = 0; j < 4; ++j) o8[64 * j] = (unsigned long long)pk2(v[j].x, v[j].y) | ((unsigned long long)pk2(v[j].z, v[j].w) << 32);
}
__device__ __forceinline__ int t5_bucket(int rel) {
    const int ret = rel > 0 ? 16 : 0, n = rel < 0 ? -rel : rel;
    int v;
    if (n < 8) v = n; else if (n < 12) v = 8; else if (n < 16) v = 9; else if (n < 23) v = 10; else if (n < 32) v = 11; else if (n < 46) v = 12; else if (n < 64) v = 13; else if (n < 91) v = 14; else v = 15;
    return ret + v;
}

struct Args { const float* in[32]; float* out; unsigned char* ws; int ph_lo, ph_hi, li, pad; };
__global__ void __launch_bounds__(NTHR, 2) mk_fwd(Args args) {
    extern __shared__ __attribute__((aligned(16))) unsigned char lds_raw[];
    LAS unsigned char* lds = (LAS unsigned char*)lds_raw;
    volatile LAS unsigned* MISC = (volatile LAS unsigned*)(lds + L_MISC);
    const int tid = threadIdx.x, lane = tid & 63, wave = __builtin_amdgcn_readfirstlane(tid >> 6);
    const int G = gridDim.x, bx = blockIdx.x;
    unsigned char* ws = args.ws;
    gu32* ctl = (gu32*)(ws + WS_CTL);
    float* out = args.out;
    bf16* W_IN = (bf16*)(ws + WS_WIN); bf16* W_OUT = (bf16*)(ws + WS_WOUT); bf16* W_CQ = (bf16*)(ws + WS_WCQ); bf16* W_CKV = (bf16*)(ws + WS_WCKV); bf16* W_CO = (bf16*)(ws + WS_WCO);
    bf16* W1 = (bf16*)(ws + WS_W1); bf16* W2 = (bf16*)(ws + WS_W2);
    bf16* MEMN = (bf16*)(ws + WS_MEMN); bf16* KVC = (bf16*)(ws + WS_KVC); float* SS = (float*)(ws + WS_SS); bf16* H = (bf16*)(ws + WS_H); bf16* PROJ = (bf16*)(ws + WS_PROJ);
    bf16* ACT = (bf16*)(ws + WS_ACT); bf16* QC = (bf16*)(ws + WS_QC); bf16* CO = (bf16*)(ws + WS_CO); bf16* TPERM = (bf16*)(ws + WS_TPERM);
    bf16* X1B = (bf16*)(ws + WS_X1B); bf16* X2B = (bf16*)(ws + WS_X2B); bf16* T = (bf16*)(ws + WS_T); float* SSX1 = (float*)(ws + WS_SSX1);
    float* NEGC = (float*)(ws + WS_NEGC); float* LOGF = (float*)(ws + WS_LOGF); float* SSKV = (float*)(ws + WS_SSKV); float* SSQC = (float*)(ws + WS_SSQC);
    int* CHOICE = (int*)(ws + WS_CHOICE); int* SLOTTOK = (int*)(ws + WS_SLOTTOK); float* SLOTW = (float*)(ws + WS_SLOTW); int* CHUNKCNT = (int*)(ws + WS_CHUNKCNT); int* MOESEG = (int*)(ws + WS_MOESEG); int* TOKSLOT = (int*)(ws + WS_TOKSLOT); bf16* Y = (bf16*)(ws + WS_Y);

    for (int u = tid; u < (LDS_BYTES - L_MISC) / 4; u += NTHR) ((LAS unsigned*)(lds + L_MISC))[u] = 0u;
    __syncthreads();
    XcdBarrier bar; bar.bar = (unsigned*)(ctl + CW_BAR) + args.li * XCD_BAR_WORDS; bar.x = 0; bar.st = nullptr;
    if (MK_ONE_LAUNCH) bar = xcd_barrier_post((unsigned*)(ctl + CW_BAR) + args.li * XCD_BAR_WORDS, MISC + 8);
    const int lo = args.ph_lo, hi = args.ph_hi;
#ifndef MK_PHMASK
#define MK_PHMASK 0x1FFF
#endif
#define IN(k) (((MK_PHMASK >> (k)) & 1) && lo <= (k) && (k) < hi)
#define SEAM(k) do { if (MK_ONE_LAUNCH && (k) + 1 < hi) xcd_barrier(bar); } while (0)

    if (IN(0)) {
        const int gw = bx * NWAVES + wave, NGW = G * NWAVES;
        LAS float* scr = (LAS float*)(lds + wave * 8704);
        LAS float* wf = (LAS float*)(lds + 73728);
        const float* w_in = args.in[4];
        for (int i = tid; i < 4096; i += NTHR) { const int k = i >> 2, j = i & 3; wf[j * 1024 + k] = w_in[(size_t)k * INCOLS + PROJW + j]; }
        constexpr int I_IN = 16 * 96, I_SQ = 16 * 32, I_CKV = 16 * 64, I_E = 16 * 256;
        constexpr int NITEMS = I_IN + 3 * I_SQ + I_CKV + 3 * I_E;
        for (int it = gw; it < NITEMS; it += NGW) {
            int r = it;
            if (r < I_IN) { tr_item(w_in, INCOLS, 64 * (r / 96), 32 * (r % 96), W_IN, 32 * (r % 96), DM, scr, lane); continue; } r -= I_IN;
            if (r < I_SQ) { tr_item(args.in[16], DM, 64 * (r / 32), 32 * (r % 32), W_OUT, 32 * (r % 32), DM, scr, lane); continue; } r -= I_SQ;
            if (r < I_SQ) { tr_item(args.in[19], DM, 64 * (r / 32), 32 * (r % 32), W_CQ, 32 * (r % 32), DM, scr, lane, args.in[17]); continue; } r -= I_SQ;
            if (r < I_SQ) { tr_item(args.in[23], DM, 64 * (r / 32), 32 * (r % 32), W_CO, 32 * (r % 32), DM, scr, lane); continue; } r -= I_SQ;
            if (r < I_CKV) { tr_item(args.in[20], 2 * DM, 64 * (r / 64), 32 * (r % 64), W_CKV, 32 * (r % 64), DM, scr, lane); continue; } r -= I_CKV;
            if (r < 2 * I_E) {
                const int up = r >= I_E ? 1 : 0; r -= up * I_E; const int e = r >> 8, q = r & 255, kb = q >> 4, nb = q & 15, c0 = 32 * nb;
                const float* src = (up ? args.in[30] : args.in[29]) + (size_t)e * DM * DEXP;
                tr_item(src, DEXP, 64 * kb, c0, W1, e * 1024 + (c0 >> 7) * 256 + up * 128 + (c0 & 127), DM, scr, lane); continue; } r -= 2 * I_E;
            { const int e = r >> 8, q = r & 255, kb = q >> 5, nb = q & 31;
              tr_item(args.in[31] + (size_t)e * DEXP * DM, DM, 64 * kb, 32 * nb, W2, e * 1024 + 32 * nb, DEXP, scr, lane); }
        }
        __syncthreads();
        {
            const float* x = args.in[0]; const float* g = args.in[3]; const float* bfg = args.in[5];
            f32x4 gv[4];
#pragma unroll
            for (int j = 0; j < 4; ++j) gv[j] = *((const GAS f32x4*)g + lane + 64 * j);
            for (int m = gw; m < NTOK; m += NGW) {
                f32x4 v[4]; const float rstd = row_load_rstd(x + (size_t)m * DM, lane, v);
                float d0 = 0.f, d1 = 0.f, d2 = 0.f, d3 = 0.f;
#pragma unroll
                for (int j = 0; j < 4; ++j) { v[j] = v[j] * rstd * gv[j];
                    const f32x4 w0 = *(const LAS f32x4*)(wf + 4 * lane + 256 * j), w1 = *(const LAS f32x4*)(wf + 1024 + 4 * lane + 256 * j), w2 = *(const LAS f32x4*)(wf + 2048 + 4 * lane + 256 * j), w3 = *(const LAS f32x4*)(wf + 3072 + 4 * lane + 256 * j);
                    d0 += (v[j].x * w0.x + v[j].y * w0.y) + (v[j].z * w0.z + v[j].w * w0.w); d1 += (v[j].x * w1.x + v[j].y * w1.y) + (v[j].z * w1.z + v[j].w * w1.w);
                    d2 += (v[j].x * w2.x + v[j].y * w2.y) + (v[j].z * w2.z + v[j].w * w2.w); d3 += (v[j].x * w3.x + v[j].y * w3.y) + (v[j].z * w3.z + v[j].w * w3.w); }
                row_store_bf16(H + (size_t)m * DM, lane, v);
                d0 = wave_sum(d0); d1 = wave_sum(d1); d2 = wave_sum(d2); d3 = wave_sum(d3);
                if (lane < 4) { const float z = (lane == 0 ? d0 : lane == 1 ? d1 : lane == 2 ? d2 : d3) + bfg[lane];
                    const float ls = fminf(z, 0.f) - log1pf(expf(-fabsf(z)));
                    LOGF[(size_t)((m >> 11) * 4 + lane) * SEQ + (m & (SEQ - 1))] = ls; }
            }
        }
        {
            const float* mem = args.in[1]; const float* g = args.in[18];
            f32x4 gv[4];
#pragma unroll
            for (int j = 0; j < 4; ++j) gv[j] = *((const GAS f32x4*)g + lane + 64 * j);
            for (int m = gw; m < MROWS; m += NGW) { f32x4 v[4]; const float rstd = row_load_rstd(mem + (size_t)m * DM, lane, v);
#pragma unroll
                for (int j = 0; j < 4; ++j) v[j] = v[j] * rstd * gv[j];
                row_store_bf16(MEMN + (size_t)m * DM, lane, v); }
        }
        SEAM(0);
    }

    if (IN(1)) {
        for (int bh = bx; bh < BATCH * 4; bh += G) {
            LAS float* wt = (LAS float*)lds;
            const f32x4 v = *(const f32x4*)(LOGF + (size_t)bh * SEQ + 4 * tid);
            const float c0 = v.x, c1 = c0 + v.y, c2 = c1 + v.z, c3 = c2 + v.w;
            float s = c3;
#pragma unroll
            for (int o = 1; o < 64; o <<= 1) { const float n = __shfl_up(s, o); if (lane >= o) s += n; }
            if (lane == 63) wt[wave] = s;
            __syncthreads();
            float base = s - c3;
            for (int w = 0; w < wave; ++w) base += wt[w];
            *(f32x4*)(NEGC + (size_t)bh * SEQ + 4 * tid) = (f32x4){-(base + c0) * LOG2E, -(base + c1) * LOG2E, -(base + c2) * LOG2E, -(base + c3) * LOG2E};
            __syncthreads();
        }
        { pg8::Gemm g{H, W_IN, NTOK, PROJW, DM}; pg8::StaticOrder S; S.init(NTOK, PROJW, G, bx);
          pg8::EpiBf16SS E{PROJ, PROJW, SS, 96, 0x3CFu, -1, nullptr, 0};
          pg8::gemm_phase<pg8::EpiBf16SS, pg8::StaticOrder, true, true>(lds, g, S, E); }
        SEAM(1);
    }

    if (IN(2)) {
        att::Ptrs P; P.PROJ = PROJ; P.SS = SS; P.NEGC = NEGC; P.QC = QC; P.SSQC = SSQC; P.KVC = KVC; P.SSKV = SSKV; P.MIX = H; P.CO = CO;
        P.g_fox_out = args.in[15]; P.g_subln = args.in[12];
        { float a = args.in[8][lane] * args.in[9][lane], c = args.in[10][lane] * args.in[11][lane]; a = wave_sum(a); c = wave_sum(c);
          const float lam_init = 0.8f - 0.6f; P.lam = expf(a) - expf(c) + lam_init; P.one_m_lam_init = 1.0f - lam_init; }
        LAS float* wsf = (LAS float*)(lds + L_WSF) + wave * 64; LAS float* GQ = (LAS float*)(lds + L_GQ); LAS float* BT = (LAS float*)(lds + L_BT);
        { pg8::Gemm g{MEMN, W_CKV, MROWS, 2 * DM, DM}; pg8::StaticOrder S; S.init(MROWS, 2 * DM, G, bx);
          pg8::EpiBf16SS E{KVC, 2 * DM, SSKV, 64, 0x0Fu, -1, nullptr, 0};
          pg8::gemm_phase<pg8::EpiBf16SS, pg8::StaticOrder, true, true>(lds, g, S, E); }
        if (tid < 128) GQ[tid] = args.in[13][tid] * args.in[14][tid] * (0.08838834764831845f * LOG2E);
        __syncthreads();
        for (;;) {
            if (tid == 0) MISC[0] = __hip_atomic_fetch_add(ctl + CW_QFOX + 256 * args.li, 1u, RLX_AGENT);
            __syncthreads();
            const int it = (int)MISC[0];
            __syncthreads();
            if (it >= 256) break;
            const int blk = 7 - (it >> 5), bh = it & 31;
#ifndef MK_NO_FOX
            att::attn_unit<att::FOX>(P, bh >> 2, bh & 3, blk, lds, wsf, GQ, BT);
#endif
        }
        __syncthreads();
        if (tid < 64) GQ[tid] = args.in[6][tid] * args.in[7][tid] * (0.125f * LOG2E);
        for (int i = tid; i < 4 * att::BT_N; i += NTHR) { const int hh = i / att::BT_N, rel = i % att::BT_N - att::BT_OFF; BT[i] = args.in[2][t5_bucket(rel) * 4 + hh] * LOG2E; }
        __syncthreads();
        for (;;) {
            if (tid == 0) MISC[0] = __hip_atomic_fetch_add(ctl + CW_QDIFF + 256 * args.li, 1u, RLX_AGENT);
            __syncthreads();
            const int it = (int)MISC[0];
            __syncthreads();
            if (it >= 512) break;
            const int blk = 15 - (it >> 5), bh = it & 31;
#ifndef MK_NO_DIFF
            att::attn_unit<att::DIFF>(P, bh >> 2, bh & 3, blk, lds, wsf, GQ, BT + (bh & 3) * att::BT_N);
#endif
        }
        SEAM(2);
    }

    if (IN(3)) {
        pg8::Gemm g{H, W_OUT, NTOK, DM, DM}; pg8::StaticOrder S; S.init(NTOK, DM, G, bx);
        pg8::EpiResBf16 E{args.in[0], nullptr, X1B, DM, SSX1, 32};
        pg8::gemm_phase<pg8::EpiResBf16, pg8::StaticOrder, true, true>(lds, g, S, E);
        SEAM(3);
    }


    if (IN(5)) {
        pg8::Gemm g{X1B, W_CQ, NTOK, DM, DM}; pg8::StaticOrder S; S.init(NTOK, DM, G, bx);
        LAS float* rsl = (LAS float*)(lds + L_BT);
        { pg8::Unit u;
          _Pragma("unroll") for (int i = 0; i < 4; ++i) if (S.next(i, u)) { const float* sp = SSX1 + (size_t)(u.pm * 256 + (tid >> 1)) * 32 + (tid & 1) * 16;
              const f32x4 a = *(const f32x4*)sp, b = *(const f32x4*)(sp + 4), c = *(const f32x4*)(sp + 8), d = *(const f32x4*)(sp + 12);
              float s = (((a.x + a.y) + (a.z + a.w)) + ((b.x + b.y) + (b.z + b.w))) + (((c.x + c.y) + (c.z + c.w)) + ((d.x + d.y) + (d.z + d.w)));
              s += __shfl_xor(s, 1);
              if ((tid & 1) == 0) rsl[i * 256 + (tid >> 1)] = 1.0f / sqrtf(s * (1.f / DM) + EPS); } }
        __syncthreads();
        pg8::EpiBf16SS E{QC, DM, SSQC, 32, 0xFu, -1, rsl, 0};
        pg8::gemm_phase<pg8::EpiBf16SS, pg8::StaticOrder, true, true>(lds, g, S, E);
        SEAM(5);
    }

    if (IN(6)) {
        att::Ptrs P; P.PROJ = PROJ; P.SS = SS; P.NEGC = NEGC; P.QC = QC; P.SSQC = SSQC; P.KVC = KVC; P.SSKV = SSKV; P.MIX = H; P.CO = CO;
        P.g_fox_out = args.in[15]; P.g_subln = args.in[12]; P.lam = 0.f; P.one_m_lam_init = 1.f;
        LAS float* wsf = (LAS float*)(lds + L_WSF) + wave * 64; LAS float* GQ = (LAS float*)(lds + L_GQ); LAS float* BT = (LAS float*)(lds + L_BT);
        if (tid < 256) GQ[tid] = args.in[21][tid] * args.in[22][tid] * (0.0625f * LOG2E);
        __syncthreads();
        for (int it = bx; it < 512; it += G) { const int bh = it >> 4, blk = it & 15; att::attn_unit<att::CROSS>(P, bh >> 2, bh & 3, blk, lds, wsf, GQ, BT); }
        SEAM(6);
    }

    if (IN(7)) {
        pg8::Gemm g{CO, W_CO, NTOK, DM, DM}; pg8::StaticOrder S; S.init(NTOK, DM, G, bx);
        pg8::EpiResBf16 E{nullptr, X1B, X2B, DM, nullptr, 0};
        pg8::gemm_phase<pg8::EpiResBf16, pg8::StaticOrder, true, true>(lds, g, S, E);
        SEAM(7);
    }

    if (IN(8)) {
        LAS float* WR = (LAS float*)lds;
        LAS int* cntL = (LAS int*)(lds + 20 * 1024 * 4);
        for (int i = tid; i < 4096; i += NTHR) WR[(i & 3) * 1024 + (i >> 2)] = args.in[25][i];
        for (int i = tid; i < 16384; i += NTHR) WR[(4 + (i & 15)) * 1024 + (i >> 4)] = args.in[27][i];
        const float* g = args.in[24]; const float* bgr = args.in[26]; const float* ber = args.in[28];
        f32x4 gv[4];
#pragma unroll
        for (int j = 0; j < 4; ++j) gv[j] = *(const f32x4*)(g + (j >> 1) * 512 + 8 * lane + (j & 1) * 4);
        for (int c = bx; c < NTOK / 64; c += G) {
            if (tid < 16) cntL[tid] = 0;
            __syncthreads();
#pragma unroll 1
            for (int i4 = 0; i4 < 2; ++i4) {
                const int m0 = c * 64 + wave * 8 + i4 * 4;
                f32x4 v[4][4];
#pragma unroll
                for (int r = 0; r < 4; ++r) { const v4u a = *((const GAS v4u*)(X2B + (size_t)(m0 + r) * DM) + lane), b = *((const GAS v4u*)(X2B + (size_t)(m0 + r) * DM) + 64 + lane);
                    v[r][0] = (f32x4){__uint_as_float(a.x << 16), __uint_as_float(a.x & 0xffff0000u), __uint_as_float(a.y << 16), __uint_as_float(a.y & 0xffff0000u)};
                    v[r][1] = (f32x4){__uint_as_float(a.z << 16), __uint_as_float(a.z & 0xffff0000u), __uint_as_float(a.w << 16), __uint_as_float(a.w & 0xffff0000u)};
                    v[r][2] = (f32x4){__uint_as_float(b.x << 16), __uint_as_float(b.x & 0xffff0000u), __uint_as_float(b.y << 16), __uint_as_float(b.y & 0xffff0000u)};
                    v[r][3] = (f32x4){__uint_as_float(b.z << 16), __uint_as_float(b.z & 0xffff0000u), __uint_as_float(b.w << 16), __uint_as_float(b.w & 0xffff0000u)}; }
#pragma unroll
                for (int r = 0; r < 4; ++r) { float s = 0.f;
#pragma unroll
                    for (int j = 0; j < 4; ++j) s += (v[r][j].x * v[r][j].x + v[r][j].y * v[r][j].y) + (v[r][j].z * v[r][j].z + v[r][j].w * v[r][j].w);
                    const float rstd = 1.0f / sqrtf(wave_sum(s) * (1.f / DM) + EPS);
#pragma unroll
                    for (int j = 0; j < 4; ++j) v[r][j] = v[r][j] * rstd * gv[j];
                    v4u oa, ob; oa.x = pk2(v[r][0].x, v[r][0].y); oa.y = pk2(v[r][0].z, v[r][0].w); oa.z = pk2(v[r][1].x, v[r][1].y); oa.w = pk2(v[r][1].z, v[r][1].w);
                    ob.x = pk2(v[r][2].x, v[r][2].y); ob.y = pk2(v[r][2].z, v[r][2].w); ob.z = pk2(v[r][3].x, v[r][3].y); ob.w = pk2(v[r][3].z, v[r][3].w);
                    *((GAS v4u*)(T + (size_t)(m0 + r) * DM) + lane) = oa; *((GAS v4u*)(T + (size_t)(m0 + r) * DM) + 64 + lane) = ob; }
                float gl[4][4];
#pragma unroll
                for (int q = 0; q < 4; ++q) { float a0 = 0.f, a1 = 0.f, a2 = 0.f, a3 = 0.f;
#pragma unroll
                    for (int j = 0; j < 4; ++j) { const f32x4 w = *(const LAS f32x4*)(WR + q * 1024 + (j >> 1) * 512 + 8 * lane + (j & 1) * 4);
                        a0 += (v[0][j].x * w.x + v[0][j].y * w.y) + (v[0][j].z * w.z + v[0][j].w * w.w); a1 += (v[1][j].x * w.x + v[1][j].y * w.y) + (v[1][j].z * w.z + v[1][j].w * w.w);
                        a2 += (v[2][j].x * w.x + v[2][j].y * w.y) + (v[2][j].z * w.z + v[2][j].w * w.w); a3 += (v[3][j].x * w.x + v[3][j].y * w.y) + (v[3][j].z * w.z + v[3][j].w * w.w); }
                    gl[0][q] = wave_sum(a0) + bgr[q]; gl[1][q] = wave_sum(a1) + bgr[q]; gl[2][q] = wave_sum(a2) + bgr[q]; gl[3][q] = wave_sum(a3) + bgr[q]; }
#pragma unroll
                for (int r = 0; r < 4; ++r) {
                    int gi = 0; float gm = gl[r][0];
#pragma unroll
                    for (int q = 1; q < 4; ++q) if (gl[r][q] > gm) { gm = gl[r][q]; gi = q; }
                    float gs = 0.f;
#pragma unroll
                    for (int q = 0; q < 4; ++q) gs += expf(gl[r][q] - gm);
                    const float pg = 1.0f / gs;
                    gi = __builtin_amdgcn_readfirstlane(gi);
                    float el[4];
#pragma unroll
                    for (int q = 0; q < 4; ++q) { float a = 0.f; const LAS float* wp = WR + (4 + 4 * gi + q) * 1024 + 8 * lane;
#pragma unroll
                        for (int j = 0; j < 4; ++j) { const f32x4 w = *(const LAS f32x4*)(wp + (j >> 1) * 512 + (j & 1) * 4); a += (v[r][j].x * w.x + v[r][j].y * w.y) + (v[r][j].z * w.z + v[r][j].w * w.w); }
                        el[q] = wave_sum(a) + ber[4 * gi + q]; }
                    int i0 = 0; float mx0 = el[0];
#pragma unroll
                    for (int q = 1; q < 4; ++q) if (el[q] > mx0) { mx0 = el[q]; i0 = q; }
                    int i1 = -1; float mx1 = -__builtin_inff();
#pragma unroll
                    for (int q = 0; q < 4; ++q) if (q != i0 && el[q] > mx1) { mx1 = el[q]; i1 = q; }
                    const float e1 = expf(mx1 - mx0), w0 = pg / (1.0f + e1), w1 = pg * e1 / (1.0f + e1);
                    if (lane == 0) { const int ea = gi * 4 + i0, eb = gi * 4 + i1; *(int4*)(CHOICE + (size_t)(m0 + r) * 4) = make_int4(ea, eb, __float_as_int(w0), __float_as_int(w1));
                        __hip_atomic_fetch_add(cntL + ea, 1, __ATOMIC_RELAXED, __HIP_MEMORY_SCOPE_WORKGROUP); __hip_atomic_fetch_add(cntL + eb, 1, __ATOMIC_RELAXED, __HIP_MEMORY_SCOPE_WORKGROUP); }
                }
            }
            __syncthreads();
            if (tid < 16) CHUNKCNT[c * 16 + tid] = cntL[tid];
            __syncthreads();
        }
        SEAM(8);
    }

    if (IN(9)) {
        LAS int* cc = (LAS int*)lds;
        LAS int* tot = cc + 4096; LAS int* pre = tot + 16; LAS int* segs = pre + 16; LAS int* chL = segs + 16; LAS int* slotL = chL + 256;
        for (int i = tid; i < 4096; i += NTHR) cc[i] = CHUNKCNT[i];
        __syncthreads();
        if (tid < 16) { int s = 0; for (int c = 0; c < 256; ++c) s += cc[c * 16 + tid]; tot[tid] = s; }
        __syncthreads();
        if (tid < 16) { int st = 0; for (int e = 0; e < tid; ++e) st += (tot[e] + 255) & ~255; segs[tid] = st; }
        __syncthreads();
        if (bx == 0 && tid < 16) { MOESEG[2 * tid] = segs[tid]; MOESEG[2 * tid + 1] = tot[tid]; }
        for (int c = bx; c < NTOK / 64; c += G) {
            if (tid < 16) { int s = 0; for (int c2 = 0; c2 < c; ++c2) s += cc[c2 * 16 + tid]; pre[tid] = segs[tid] + s; }
            if (tid < 256) chL[tid] = CHOICE[(size_t)c * 256 + tid];
            __syncthreads();
            if (tid < 16) { int pos = pre[tid];
                for (int i = 0; i < 64; ++i) { if (chL[i * 4] == tid) slotL[i * 2] = pos++; if (chL[i * 4 + 1] == tid) slotL[i * 2 + 1] = pos++; } }
            __syncthreads();
            for (int i = 0; i < 8; ++i) { const int tl = wave * 8 + i, m = c * 64 + tl;
                const v4u a = *((const GAS v4u*)(T + (size_t)m * DM) + lane), b = *((const GAS v4u*)(T + (size_t)m * DM) + 64 + lane);
#pragma unroll
                for (int k = 0; k < 2; ++k) { const int slot = slotL[tl * 2 + k];
                    *((GAS v4u*)(TPERM + (size_t)slot * DM) + lane) = a; *((GAS v4u*)(TPERM + (size_t)slot * DM) + 64 + lane) = b;
                    if (lane == 0) { SLOTTOK[slot] = m; SLOTW[slot] = __int_as_float(chL[tl * 4 + 2 + k]); TOKSLOT[m * 2 + k] = slot; } } }
            __syncthreads();
        }
        SEAM(9);
    }

    if (IN(10) || IN(11)) {
        LAS int* tile_e = (LAS int*)(lds + L_TILEE);
        int nt = 0;
        for (int e = 0; e < NEXP; ++e) { const int t0 = MOESEG[2 * e] >> 8, n = (MOESEG[2 * e + 1] + 255) >> 8; if (tid < n) tile_e[t0 + tid] = e; nt += n; }
        __syncthreads();
        if (IN(10)) {
            pg8::Gemm g{TPERM, W1, SLOT_MAX, NEXP * 1024, DM}; pg8::MoeOrder S{nt, G, bx, tile_e};
            pg8::EpiMoe1 E{ACT, DEXP};
            pg8::gemm_phase<pg8::EpiMoe1, pg8::MoeOrder, true, true>(lds, g, S, E);
            SEAM(10);
        }
        if (IN(11)) {
            pg8::Gemm g{ACT, W2, SLOT_MAX, NEXP * 1024, DEXP}; pg8::MoeOrder S{nt, G, bx, tile_e};
            pg8::EpiBf16SS E{Y, DM, nullptr, 0, 0u, 3, nullptr, 0};
            pg8::gemm_phase<pg8::EpiBf16SS, pg8::MoeOrder, true, true>(lds, g, S, E);
            SEAM(11);
        }
    }

    if (IN(12)) {
        const int gw = bx * NWAVES + wave, NGW = G * NWAVES;
        for (int m = gw; m < NTOK; m += NGW) {
            const int4 ch = *(const int4*)(CHOICE + (size_t)m * 4); const int s0 = TOKSLOT[m * 2], s1 = TOKSLOT[m * 2 + 1];
            const float w0 = __int_as_float(ch.z), w1 = __int_as_float(ch.w);
            GAS f32x4* orow = (GAS f32x4*)(out + (size_t)m * DM) + lane; const GAS unsigned long long* xrow = (const GAS unsigned long long*)(X2B + (size_t)m * DM) + lane;
            const GAS unsigned long long* y0 = (const GAS unsigned long long*)(Y + (size_t)s0 * DM) + lane; const GAS unsigned long long* y1 = (const GAS unsigned long long*)(Y + (size_t)s1 * DM) + lane;
#pragma unroll
            for (int j = 0; j < 4; ++j) { const unsigned long long xb = xrow[64 * j]; const unsigned x0 = (unsigned)xb, x1 = (unsigned)(xb >> 32);
                f32x4 v = (f32x4){__uint_as_float(x0 << 16), __uint_as_float(x0 & 0xffff0000u), __uint_as_float(x1 << 16), __uint_as_float(x1 & 0xffff0000u)}; const unsigned long long a = y0[64 * j], b = y1[64 * j];
                const unsigned a0 = (unsigned)a, a1 = (unsigned)(a >> 32), b0 = (unsigned)b, b1 = (unsigned)(b >> 32);
                v.x += w0 * __uint_as_float(a0 << 16) + w1 * __uint_as_float(b0 << 16); v.y += w0 * __uint_as_float(a0 & 0xffff0000u) + w1 * __uint_as_float(b0 & 0xffff0000u);
                v.z += w0 * __uint_as_float(a1 << 16) + w1 * __uint_as_float(b1 << 16); v.w += w0 * __uint_as_float(a1 & 0xffff0000u) + w1 * __uint_as_float(b1 & 0xffff0000u);
                orow[64 * j] = v; }
        }
    }
#undef IN
#undef SEAM
}

extern "C" void kernel_launch(void* const* d_in, const int* in_sizes, int n_in, void* d_out, int out_size, void* d_ws, size_t ws_size, hipStream_t stream) {
    static int grid = 0;
    if (grid == 0) {
        if (n_in != 32 || out_size != NTOK * DM || ws_size < WS_END) { fprintf(stderr, "kernel_launch: unexpected shapes (n_in %d out %d ws %zu)\n", n_in, out_size, ws_size); grid = -1; return; }
        int dev = 0, cus = 0, per_cu = 0;
        if (hipGetDevice(&dev) != hipSuccess || hipDeviceGetAttribute(&cus, hipDeviceAttributeMultiprocessorCount, dev) != hipSuccess) { grid = -1; return; }
        if (hipFuncSetAttribute((const void*)mk_fwd, hipFuncAttributeMaxDynamicSharedMemorySize, LDS_BYTES) != hipSuccess) { fprintf(stderr, "kernel_launch: hipFuncSetAttribute failed\n"); grid = -1; return; }
        if (hipOccupancyMaxActiveBlocksPerMultiprocessor(&per_cu, (const void*)mk_fwd, NTHR, LDS_BYTES) != hipSuccess || per_cu < 1) { fprintf(stderr, "kernel_launch: occupancy query says %d\n", per_cu); }
        (void)hipGetLastError();
        grid = cus;
    }
    if (grid < 0) return;
    (void)hipMemsetAsync((char*)d_ws + WS_CTL, 0, CTL_ZERO_BYTES, stream);
    Args a{};
    for (int i = 0; i < 32; ++i) a.in[i] = (const float*)d_in[i];
    a.out = (float*)d_out; a.ws = (unsigned char*)d_ws;
#if defined(MK_REP)
    a.ph_lo = 0; a.ph_hi = MK_REP + 1; a.li = 0;
    hipLaunchKernelGGL(mk_fwd, dim3(grid), dim3(NTHR), LDS_BYTES, stream, a);
    a.ph_lo = MK_REP; a.ph_hi = MK_PH_END; a.li = 1;
    hipLaunchKernelGGL(mk_fwd, dim3(grid), dim3(NTHR), LDS_BYTES, stream, a);
#elif MK_ONE_LAUNCH
    a.ph_lo = 0; a.ph_hi = MK_PH_END;
    hipLaunchKernelGGL(mk_fwd, dim3(grid), dim3(NTHR), LDS_BYTES, stream, a);
#else
    for (int p = 0; p < MK_PH_END; ++p) { a.ph_lo = p; a.ph_hi = p + 1; hipLaunchKernelGGL(mk_fwd, dim3(grid), dim3(NTHR), LDS_BYTES, stream, a); }
#endif
}
```

```cpp
#include <hip/hip_runtime.h>
#include <cstdio>
#include <cstdint>
namespace pg8 {
#define PG8_LAS __attribute__((address_space(3)))
typedef unsigned short bf16_t;
typedef short bf16x8 __attribute__((ext_vector_type(8)));
typedef float f32x4 __attribute__((ext_vector_type(4)));
typedef unsigned u32x4 __attribute__((ext_vector_type(4)));
constexpr int BM = 256, BK = 64, HALF = 128, HTB = HALF * BK * 2  , STAGE_BYTES = 8 * HTB, NXCD = 8, WGM = 8;

__host__ __device__ __forceinline__ int lds_byte(int r, int c) { const int st = (r >> 4) * 2 + (c >> 5), rr = r & 15, cc = c & 31, ob = rr * 64 + cc * 2; return st * 1024 + (ob ^ (((ob >> 9) & 1) << 5)); }
__host__ __device__ __forceinline__ void stage_rc(int b, int& R, int& C) { const int st = b / 1024, sb = b % 1024, swz = sb ^ (((sb >> 9) & 1) << 5); R = (st >> 1) * 16 + swz / 64; C = (st & 1) * 32 + (swz % 64) / 2; }
__host__ __device__ __forceinline__ int perm32(int rho) { const int n = rho >> 4, i = rho & 15; return 8 * (i >> 2) + 4 * n + (i & 3); }

struct Unit { int pm, pn; };
struct Gemm { const bf16_t* A; const bf16_t* Bt; int M, N, K; };

struct StaticOrder {
    int nM, nN, nwg, G, c;
    __host__ __device__ void init(int M, int N, int G_, int c_) { nM = M / BM; nN = N / BM; nwg = nM * nN; G = G_; c = c_; }
    __host__ __device__ __forceinline__ bool next(int i, Unit& u) const {
        const long L = (long)i * G + c; if (L >= nwg) return false;
        int wgid = (int)L; { const int q = nwg / NXCD, r = nwg % NXCD, xcd = wgid % NXCD, off = wgid / NXCD; wgid = (xcd < r ? xcd * (q + 1) : r * (q + 1) + (xcd - r) * q) + off; }
        const int nig = WGM * nN, gid = wgid / nig, fm = gid * WGM, gsz = (nM - fm) < WGM ? (nM - fm) : WGM;
        u.pm = fm + ((wgid % nig) % gsz); u.pn = (wgid % nig) / gsz; return true;
    }
    __device__ __forceinline__ void a_ready(const Unit&) const {}
    __device__ __forceinline__ void done(const Unit&) const {}
};

__device__ __forceinline__ unsigned cvt_pk_bf16(float lo, float hi) { unsigned r; asm volatile("v_cvt_pk_bf16_f32 %0, %1, %2" : "=v"(r) : "v"(lo), "v"(hi)); return r; }
template <class Epi, class Sched, bool ALIGN_EPI = false, bool SP2 = false>
__device__ __forceinline__ void gemm_phase(PG8_LAS unsigned char* lds, const Gemm g, const Sched& S, const Epi& E) {
    const int tid = threadIdx.x, wid = __builtin_amdgcn_readfirstlane(tid >> 6), lane = tid & 63, wr = wid >> 2, wc = wid & 3, fr = lane & 15, fq = lane >> 4;
    const int K = g.K, nt = K / BK;
    unsigned voffA[2], voffB[2];
#pragma unroll
    for (int i = 0; i < 2; ++i) { int R, C; stage_rc(tid * 16 + i * 8192, R, C); const int Rb = Epi::PERM ? ((R & ~31) + perm32(R & 31)) : R;
        voffA[i] = (unsigned)(R * K + C) * 2u; voffB[i] = (unsigned)(Rb * K + C) * 2u; }
    const size_t kstep = (size_t)(BK * 2);
    const size_t hstep = (size_t)HALF * K * 2;
    const size_t tstep = 2 * hstep;
    const unsigned ldsw = (unsigned)wid * 1024u;
    const int aoff = lds_byte(wr * 64 + fr, fq * 8), boff = lds_byte(wc * 32 + fr, fq * 8);
#define PG8_SA(b, h) (((b) * 2 + (h)) * HTB)
#define PG8_SB(b, h) ((4 + (b) * 2 + (h)) * HTB)
#define PG8_STAGE(bufoff, gbase, voff) do { _Pragma("unroll") for (int _i = 0; _i < 2; ++_i) \
        __builtin_amdgcn_global_load_lds((const unsigned*)((const char*)(gbase) + (voff)[_i]), (PG8_LAS unsigned*)(lds + (bufoff) + ldsw + _i * 8192), 16, 0, 0); } while (0)
#define PG8_LDA(dst, b, h) do { _Pragma("unroll") for (int m = 0; m < 4; ++m) _Pragma("unroll") for (int k = 0; k < 2; ++k) dst[m][k] = *(const PG8_LAS bf16x8*)(lds + PG8_SA(b, h) + aoff + m * 2048 + k * 1024); } while (0)
#define PG8_LDB(dst, b, h) do { _Pragma("unroll") for (int n = 0; n < 2; ++n) _Pragma("unroll") for (int k = 0; k < 2; ++k) dst[n][k] = *(const PG8_LAS bf16x8*)(lds + PG8_SB(b, h) + boff + n * 2048 + k * 1024); } while (0)
#define PG8_MMA(ai, bj, At, Bt) do { __builtin_amdgcn_s_setprio(1); _Pragma("unroll") for (int m = 0; m < 4; ++m) _Pragma("unroll") for (int n = 0; n < 2; ++n) _Pragma("unroll") for (int k = 0; k < 2; ++k) \
        acc[ai][bj][m][n] = __builtin_amdgcn_mfma_f32_16x16x32_bf16(Bt[n][k], At[m][k], acc[ai][bj][m][n], 0, 0, 0); __builtin_amdgcn_s_setprio(0); } while (0)
#define PG8_WAIT_V(n) asm volatile("s_waitcnt vmcnt(" #n ")" ::: "memory")
#define PG8_WAIT_L(n) asm volatile("s_waitcnt lgkmcnt(" #n ")" ::: "memory")
#define PG8_BAR __builtin_amdgcn_s_barrier()
#define PG8_SCHED __builtin_amdgcn_sched_barrier(0)
    Unit cur, nxt; int ui = 0;
    if (!S.next(0, cur)) return;
    f32x4 acc[2][2][4][2];
#pragma unroll
    for (int a = 0; a < 2; ++a)
#pragma unroll
        for (int b = 0; b < 2; ++b)
#pragma unroll
            for (int m = 0; m < 4; ++m)
#pragma unroll
                for (int n = 0; n < 2; ++n) acc[a][b][m][n] = (f32x4){0.f, 0.f, 0.f, 0.f};
    bf16x8 At[4][2], B0[2][2], B1[2][2];
    const char* cA = (const char*)g.A + (size_t)cur.pm * tstep; const char* cB = (const char*)g.Bt + (size_t)cur.pn * tstep;
    S.a_ready(cur);
    if constexpr (SP2) {
        PG8_STAGE(PG8_SB(0, 0), cB, voffB); PG8_STAGE(PG8_SB(0, 1), cB + hstep, voffB); PG8_STAGE(PG8_SA(0, 0), cA, voffA); PG8_STAGE(PG8_SA(0, 1), cA + hstep, voffA);
        if (wr == 1) PG8_BAR;
        PG8_WAIT_V(2); PG8_BAR;
        PG8_STAGE(PG8_SB(1, 0), cB + kstep, voffB); PG8_STAGE(PG8_SA(1, 0), cA + kstep, voffA); PG8_STAGE(PG8_SB(1, 1), cB + hstep + kstep, voffB);
        PG8_WAIT_V(6); PG8_BAR;
    } else {
        PG8_STAGE(PG8_SB(0, 0), cB, voffB); PG8_STAGE(PG8_SA(0, 0), cA, voffA); PG8_STAGE(PG8_SB(0, 1), cB + hstep, voffB); PG8_STAGE(PG8_SA(0, 1), cA + hstep, voffA);
        if (wr == 1) PG8_BAR;
        PG8_WAIT_V(4); PG8_BAR;
        PG8_STAGE(PG8_SB(1, 0), cB + kstep, voffB); PG8_STAGE(PG8_SA(1, 0), cA + kstep, voffA); PG8_STAGE(PG8_SB(1, 1), cB + hstep + kstep, voffB);
        PG8_WAIT_V(6); PG8_BAR;
    }
    for (;;) {
        const bool has_next = S.next(ui + 1, nxt);
        const char* nA = has_next ? (const char*)g.A + (size_t)nxt.pm * tstep : cA; const char* nB = has_next ? (const char*)g.Bt + (size_t)nxt.pn * tstep : cB;
        for (int t = 0; t < nt; t += 2) {
            const bool last = (t == nt - 2);
            const char* a1 = cA + (size_t)(t + 1) * kstep;
            const char* a2 = last ? nA : cA + (size_t)(t + 2) * kstep; const char* b2 = last ? nB : cB + (size_t)(t + 2) * kstep;
            const char* a3 = a2 + kstep; const char* b3 = b2 + kstep;
            if (last && has_next) S.a_ready(nxt);
            if constexpr (SP2) {
            PG8_LDB(B0, 0, 0); PG8_LDB(B1, 0, 1); PG8_SCHED; PG8_LDA(At, 0, 0); PG8_STAGE(PG8_SA(1, 1), a1 + hstep, voffA);
            PG8_WAIT_V(8); PG8_WAIT_L(0); PG8_BAR; PG8_MMA(0, 0, At, B0); PG8_MMA(0, 1, At, B1); PG8_BAR; PG8_SCHED;
            PG8_LDA(At, 0, 1); PG8_STAGE(PG8_SB(0, 0), b2, voffB); PG8_STAGE(PG8_SB(0, 1), b2 + hstep, voffB); PG8_STAGE(PG8_SA(0, 0), a2, voffA);
            PG8_WAIT_V(8); PG8_WAIT_L(0); PG8_BAR; PG8_MMA(1, 0, At, B0); PG8_MMA(1, 1, At, B1); PG8_BAR; PG8_SCHED;
            PG8_LDB(B0, 1, 0); PG8_LDB(B1, 1, 1); PG8_SCHED; PG8_LDA(At, 1, 0); PG8_STAGE(PG8_SA(0, 1), a2 + hstep, voffA);
            PG8_WAIT_V(8); PG8_WAIT_L(0); PG8_BAR; PG8_MMA(0, 0, At, B0); PG8_MMA(0, 1, At, B1); PG8_BAR; PG8_SCHED;
            PG8_LDA(At, 1, 1); PG8_STAGE(PG8_SB(1, 0), b3, voffB); PG8_STAGE(PG8_SB(1, 1), b3 + hstep, voffB); PG8_STAGE(PG8_SA(1, 0), a3, voffA);
            PG8_WAIT_V(8); PG8_WAIT_L(0); PG8_BAR; PG8_MMA(1, 0, At, B0); PG8_MMA(1, 1, At, B1); PG8_BAR; PG8_SCHED;
            } else {
            PG8_LDB(B0, 0, 0); PG8_SCHED; PG8_LDA(At, 0, 0); PG8_STAGE(PG8_SA(1, 1), a1 + hstep, voffA);
            PG8_WAIT_L(8); PG8_BAR; PG8_WAIT_L(0); PG8_MMA(0, 0, At, B0); PG8_BAR; PG8_SCHED;
            PG8_LDB(B1, 0, 1); PG8_STAGE(PG8_SB(0, 0), b2, voffB);
            PG8_BAR; PG8_WAIT_L(0); PG8_MMA(0, 1, At, B1); PG8_BAR;
            PG8_LDA(At, 0, 1); PG8_STAGE(PG8_SA(0, 0), a2, voffA);
            PG8_BAR; PG8_WAIT_L(0); PG8_MMA(1, 0, At, B0); PG8_BAR; PG8_SCHED;
            PG8_STAGE(PG8_SB(0, 1), b2 + hstep, voffB);
            PG8_WAIT_V(6); PG8_BAR; PG8_MMA(1, 1, At, B1); PG8_BAR;
            PG8_LDB(B0, 1, 0); PG8_SCHED; PG8_LDA(At, 1, 0); PG8_STAGE(PG8_SA(0, 1), a2 + hstep, voffA);
            PG8_WAIT_L(8); PG8_BAR; PG8_WAIT_L(0); PG8_MMA(0, 0, At, B0); PG8_BAR; PG8_SCHED;
            PG8_LDB(B1, 1, 1); PG8_STAGE(PG8_SB(1, 0), b3, voffB);
            PG8_BAR; PG8_WAIT_L(0); PG8_MMA(0, 1, At, B1); PG8_BAR;
            PG8_LDA(At, 1, 1); PG8_STAGE(PG8_SA(1, 0), a3, voffA);
            PG8_BAR; PG8_WAIT_L(0); PG8_MMA(1, 0, At, B0); PG8_BAR; PG8_SCHED;
            PG8_STAGE(PG8_SB(1, 1), b3 + hstep, voffB);
            PG8_WAIT_V(6); PG8_BAR; PG8_MMA(1, 1, At, B1); PG8_BAR;
            }
        }
        if constexpr (ALIGN_EPI) { if (wr == 0) PG8_BAR; }
        if constexpr (!Epi::AFTER_DRAIN) { E(acc, cur, wr, wc, fr, fq); S.done(cur); }
        if (!has_next) break;
#pragma unroll
        for (int a = 0; a < 2; ++a)
#pragma unroll
            for (int b = 0; b < 2; ++b)
#pragma unroll
                for (int m = 0; m < 4; ++m)
#pragma unroll
                    for (int n = 0; n < 2; ++n) acc[a][b][m][n] = (f32x4){0.f, 0.f, 0.f, 0.f};
        cur = nxt; cA = nA; cB = nB; ++ui;
        if constexpr (ALIGN_EPI) { if (wr == 1) PG8_BAR; }
    }
    PG8_WAIT_V(0);
    if constexpr (!ALIGN_EPI) { if (wr == 0) PG8_BAR; }
    PG8_BAR;
    if constexpr (Epi::AFTER_DRAIN) { E.fused(acc, cur, wr, wc, fr, fq, lds, wid, lane); S.done(cur); }
#undef PG8_SA
#undef PG8_SB
#undef PG8_STAGE
#undef PG8_LDA
#undef PG8_LDB
#undef PG8_MMA
#undef PG8_WAIT_V
#undef PG8_WAIT_L
#undef PG8_BAR
#undef PG8_SCHED
}
}
namespace pg8 {
struct EpiBf16SS {
    static constexpr bool PERM = true, AFTER_DRAIN = false;
    bf16_t* O; int ldc; float* SS; int ssld; unsigned ssmask; int pnmask;
    const PG8_LAS float* rowscale; mutable int ord;
    __device__ __forceinline__ void operator()(const f32x4 (&acc)[2][2][4][2], const Unit& u, int wr, int wc, int fr, int fq) const {
        const int row0 = u.pm * BM + wr * 64 + fr, col0 = (u.pn & pnmask) * BM + wc * 32 + 8 * fq;
        const bool doss = ((ssmask >> u.pn) & 1u) != 0u;
#pragma unroll
        for (int ai = 0; ai < 2; ++ai)
#pragma unroll
            for (int m = 0; m < 4; ++m) { const int row = row0 + ai * HALF + m * 16; bf16_t* rowp = O + (size_t)row * ldc + col0;
#pragma unroll
                for (int bj = 0; bj < 2; ++bj) { f32x4 v0 = acc[ai][bj][m][0], v1 = acc[ai][bj][m][1];
                    if (rowscale) { const float rsc = rowscale[ord * BM + wr * 64 + fr + ai * HALF + m * 16]; v0 = v0 * rsc; v1 = v1 * rsc; }
                    u32x4 w; w.x = cvt_pk_bf16(v0[0], v0[1]); w.y = cvt_pk_bf16(v0[2], v0[3]); w.z = cvt_pk_bf16(v1[0], v1[1]); w.w = cvt_pk_bf16(v1[2], v1[3]);
                    *(u32x4*)(rowp + bj * HALF) = w;
                    if (doss) { float s = (v0[0] * v0[0] + v0[1] * v0[1]) + (v0[2] * v0[2] + v0[3] * v0[3]) + (v1[0] * v1[0] + v1[1] * v1[1]) + (v1[2] * v1[2] + v1[3] * v1[3]);
                        s += __shfl_xor(s, 16); s += __shfl_xor(s, 32);
                        if (fq == 0) SS[(size_t)row * ssld + ((u.pn * BM + bj * HALF + wc * 32) >> 5)] = s; } } }
        ++ord;
    }
};
struct EpiResF32 {
    static constexpr bool PERM = false, AFTER_DRAIN = false;
    const float* base; float* out; int ldc;
    __device__ __forceinline__ void operator()(const f32x4 (&acc)[2][2][4][2], const Unit& u, int wr, int wc, int fr, int fq) const {
        const int col0 = u.pn * BM + wc * 32 + 4 * fq;
#pragma unroll
        for (int ai = 0; ai < 2; ++ai)
#pragma unroll
            for (int m = 0; m < 4; ++m) { const size_t off = (size_t)(u.pm * BM + ai * HALF + wr * 64 + m * 16 + fr) * ldc + col0;
#pragma unroll
                for (int bj = 0; bj < 2; ++bj)
#pragma unroll
                    for (int n = 0; n < 2; ++n) { const f32x4 bs = *(const f32x4*)(base + off + bj * HALF + n * 16); *(f32x4*)(out + off + bj * HALF + n * 16) = bs + acc[ai][bj][m][n]; }
                if (m & 1) asm volatile("" ::: "memory"); }
    }
};
struct EpiResBf16 {
    static constexpr bool PERM = true, AFTER_DRAIN = false;
    const float* basef; const bf16_t* baseh; bf16_t* O; int ldc; float* SS; int ssld;
    __device__ __forceinline__ void operator()(const f32x4 (&acc)[2][2][4][2], const Unit& u, int wr, int wc, int fr, int fq) const {
        const int row0 = u.pm * BM + wr * 64 + fr, col0 = u.pn * BM + wc * 32 + 8 * fq;
#pragma unroll
        for (int ai = 0; ai < 2; ++ai)
#pragma unroll
            for (int m = 0; m < 4; ++m) { const int row = row0 + ai * HALF + m * 16; const size_t off = (size_t)row * ldc + col0;
#pragma unroll
                for (int bj = 0; bj < 2; ++bj) { f32x4 v0 = acc[ai][bj][m][0], v1 = acc[ai][bj][m][1];
                    if (basef) { v0 = v0 + *(const f32x4*)(basef + off + bj * HALF); v1 = v1 + *(const f32x4*)(basef + off + bj * HALF + 4); }
                    else { const u32x4 b = *(const u32x4*)(baseh + off + bj * HALF);
                        v0 = v0 + (f32x4){__uint_as_float(b.x << 16), __uint_as_float(b.x & 0xffff0000u), __uint_as_float(b.y << 16), __uint_as_float(b.y & 0xffff0000u)};
                        v1 = v1 + (f32x4){__uint_as_float(b.z << 16), __uint_as_float(b.z & 0xffff0000u), __uint_as_float(b.w << 16), __uint_as_float(b.w & 0xffff0000u)}; }
                    u32x4 w; w.x = cvt_pk_bf16(v0[0], v0[1]); w.y = cvt_pk_bf16(v0[2], v0[3]); w.z = cvt_pk_bf16(v1[0], v1[1]); w.w = cvt_pk_bf16(v1[2], v1[3]);
                    *(u32x4*)(O + off + bj * HALF) = w;
                    if (SS) { float s = (v0[0] * v0[0] + v0[1] * v0[1]) + (v0[2] * v0[2] + v0[3] * v0[3]) + (v1[0] * v1[0] + v1[1] * v1[1]) + (v1[2] * v1[2] + v1[3] * v1[3]);
                        s += __shfl_xor(s, 16); s += __shfl_xor(s, 32);
                        if (fq == 0) SS[(size_t)row * ssld + ((u.pn * BM + bj * HALF + wc * 32) >> 5)] = s; } }
                if (m & 1) asm volatile("" ::: "memory"); }
    }
};
struct EpiMoe1 {
    static constexpr bool PERM = true, AFTER_DRAIN = false;
    bf16_t* ACT; int ldc;
    __device__ __forceinline__ void operator()(const f32x4 (&acc)[2][2][4][2], const Unit& u, int wr, int wc, int fr, int fq) const {
        const int row0 = u.pm * BM + wr * 64 + fr, col0 = (u.pn & 3) * HALF + wc * 32 + 8 * fq;
#pragma unroll
        for (int ai = 0; ai < 2; ++ai)
#pragma unroll
            for (int m = 0; m < 4; ++m) { float a[8];
#pragma unroll
                for (int n = 0; n < 2; ++n)
#pragma unroll
                    for (int e = 0; e < 4; ++e) { const float g = acc[ai][0][m][n][e], up = acc[ai][1][m][n][e]; a[n * 4 + e] = g * __builtin_amdgcn_rcpf(1.0f + __expf(-g)) * up; }
                u32x4 w; w.x = cvt_pk_bf16(a[0], a[1]); w.y = cvt_pk_bf16(a[2], a[3]); w.z = cvt_pk_bf16(a[4], a[5]); w.w = cvt_pk_bf16(a[6], a[7]);
                *(u32x4*)(ACT + (size_t)(row0 + ai * HALF + m * 16) * ldc + col0) = w; }
    }
};
struct EpiMoe2 {
    static constexpr bool PERM = false, AFTER_DRAIN = false;
    float* out; int ldc; const int* slot_tok; const float* slot_w; const int* seg;
    __device__ __forceinline__ void operator()(const f32x4 (&acc)[2][2][4][2], const Unit& u, int wr, int wc, int fr, int fq) const {
        const int e = u.pn >> 2, send = seg[2 * e] + seg[2 * e + 1];
        const int col0 = (u.pn & 3) * BM + wc * 32 + 4 * fq;
#pragma unroll
        for (int ai = 0; ai < 2; ++ai)
#pragma unroll
            for (int m = 0; m < 4; ++m) { const int slot = u.pm * BM + ai * HALF + wr * 64 + m * 16 + fr;
                if (slot < send) { const int tok = slot_tok[slot]; const float w = slot_w[slot]; float* op = out + (size_t)tok * ldc + col0;
#pragma unroll
                    for (int bj = 0; bj < 2; ++bj)
#pragma unroll
                        for (int n = 0; n < 2; ++n)
#pragma unroll
                            for (int q = 0; q < 4; ++q) unsafeAtomicAdd(op + bj * HALF + n * 16 + q, w * acc[ai][bj][m][n][q]); } }
    }
};
struct MoeOrder {
    int ntile, G, c; const PG8_LAS int* tile_e;
    __device__ __forceinline__ bool next(int i, Unit& u) const {
        const int L = i * G + c; if (L >= ntile * 4) return false;
        const int ti = L >> 2; u.pm = ti; u.pn = __builtin_amdgcn_readfirstlane(tile_e[ti]) * 4 + (L & 3); return true;
    }
    __device__ __forceinline__ void a_ready(const Unit&) const {}
    __device__ __forceinline__ void done(const Unit&) const {}
};
}
namespace att {
#define ALAS __attribute__((address_space(3)))
typedef unsigned short bf16_t;
typedef short bf16x8 __attribute__((ext_vector_type(8)));
typedef short s16x4 __attribute__((ext_vector_type(4)));
typedef float f32x16 __attribute__((ext_vector_type(16)));
typedef float f32x4 __attribute__((ext_vector_type(4)));
typedef unsigned u32x4 __attribute__((ext_vector_type(4)));
enum { FOX = 0, DIFF = 1, CROSS = 2 };
constexpr int SUBT = 16384;
constexpr float LOG2E = 1.4426950408889634f, NEPS = 1e-6f, THR = 8.f;
constexpr int SEQ = 2048, PROJW = 3072, DM = 1024, NMEM = 256;
constexpr int BT_N = 320, BT_OFF = 224;

template <int T> struct AC;
template <> struct AC<FOX>   { static constexpr int NKS = 8,  ROWS = 256, KSUB = 1, VSUB = 1; };
template <> struct AC<DIFF>  { static constexpr int NKS = 4,  ROWS = 128, KSUB = 1, VSUB = 1; };
template <> struct AC<CROSS> { static constexpr int NKS = 16, ROWS = 128, KSUB = 2, VSUB = 2; };

__device__ __forceinline__ int kswz(int row, int colB) { return row * 256 + (colB ^ ((row & 7) << 4)); }
__device__ __forceinline__ int v_st(int k, int c) { const int kk = (k & ~0xC) | ((k & 4) << 1) | ((k & 8) >> 1); return ((kk >> 3) * 4 + (c >> 5)) * 512 + ((kk & 7) * 32 + (c & 31)) * 2; }
__device__ __forceinline__ int v_rd_base(int lane) { return ((lane & 3) << 3) | (((lane >> 2) & 3) << 6) | (((lane >> 4) & 1) << 5) | (((lane >> 5) & 1) << 8); }
__device__ __forceinline__ int crow(int r, int hi) { return (r & 3) + 8 * (r >> 2) + 4 * hi; }
__device__ __forceinline__ unsigned cvtpk(float lo, float hi) { unsigned r; asm volatile("v_cvt_pk_bf16_f32 %0, %1, %2" : "=v"(r) : "v"(lo), "v"(hi)); return r; }
__device__ __forceinline__ float bflo(unsigned w) { return __uint_as_float(w << 16); }
__device__ __forceinline__ float bfhi(unsigned w) { return __uint_as_float(w & 0xffff0000u); }
#define ASBAR() __builtin_amdgcn_sched_barrier(0)

__device__ __forceinline__ bf16x8 qprep(u32x4 raw, float s, const ALAS float* G) {
    const f32x4 g0 = *(const ALAS f32x4*)G, g1 = *(const ALAS f32x4*)(G + 4);
    u32x4 w;
    w.x = cvtpk(bflo(raw.x) * s * g0[0], bfhi(raw.x) * s * g0[1]); w.y = cvtpk(bflo(raw.y) * s * g0[2], bfhi(raw.y) * s * g0[3]);
    w.z = cvtpk(bflo(raw.z) * s * g1[0], bfhi(raw.z) * s * g1[1]); w.w = cvtpk(bflo(raw.w) * s * g1[2], bfhi(raw.w) * s * g1[3]);
    return __builtin_bit_cast(bf16x8, w);
}

struct Ptrs {
    const bf16_t* PROJ;  const float* SS;
    const float* NEGC;
    const bf16_t* QC;    const float* SSQC;
    const bf16_t* KVC;   const float* SSKV;
    bf16_t* MIX;         bf16_t* CO;
    const float* g_fox_out; const float* g_subln;
    float lam, one_m_lam_init;
};

template <int T> constexpr int tilesz() { return (AC<T>::KSUB + AC<T>::VSUB) * SUBT; }
constexpr int KT_OFF_SELF = 65536, KT_OFF_CROSS = 131072;
__device__ __forceinline__ void dma16(const void* g, ALAS unsigned char* l) { __builtin_amdgcn_global_load_lds((const unsigned*)g, (ALAS unsigned*)l, 16, 0, 0); }
template <int T>
__device__ __forceinline__ void attn_unit(const Ptrs& P, int b, int h, int blk, ALAS unsigned char* lds, ALAS float* wsf, const ALAS float* GQ, const ALAS float* BT) {
    constexpr int NKS = AC<T>::NKS, ROWS = AC<T>::ROWS, KSUB = AC<T>::KSUB, VSUB = AC<T>::VSUB, BUFSZ = tilesz<T>();
    constexpr int KT_OFF = (T == CROSS) ? KT_OFF_CROSS : KT_OFF_SELF, STG_OFF = (T == CROSS) ? 0 : 65536;
    int tid_ = threadIdx.x; asm volatile("" : "+v"(tid_));
    const int tid = tid_, wid = __builtin_amdgcn_readfirstlane(tid >> 6), lane = tid & 63, r32 = lane & 31, hi = lane >> 5;
    const int rg = (T == FOX) ? wid : (wid & 3), sel = (T == FOX) ? 0 : (wid >> 2);
    const int P0 = blk * ROWS, qlo = P0 + 32 * rg;
    const int NT = (T == CROSS) ? NMEM / 64 : (P0 + ROWS) / 64;
    const bf16_t* Kp; const bf16_t* Vp; int kvpitch; const float* SSk; int sskld;
    if constexpr (T == FOX)  { Kp = P.PROJ + (size_t)b * SEQ * PROJW + 2048 + h * 128; Vp = Kp + 512; kvpitch = PROJW; SSk = P.SS + (size_t)b * SEQ * 96 + 64 + 4 * h; sskld = 96; }
    if constexpr (T == DIFF) { Kp = P.PROJ + (size_t)b * SEQ * PROJW + 512 + h * 128;  Vp = Kp + 512; kvpitch = PROJW; SSk = P.SS + (size_t)b * SEQ * 96 + 16 + 4 * h; sskld = 96; }
    if constexpr (T == CROSS){ Kp = P.KVC + (size_t)b * NMEM * 2048 + h * 256;         Vp = Kp + 1024; kvpitch = 2048; SSk = P.SSKV + (size_t)b * NMEM * 64 + 8 * h; sskld = 64; }
    ALAS float* KT = (ALAS float*)(lds + KT_OFF);
    for (int k = tid; k < NT * 64; k += 512) {
        const f32x4 s4 = *(const f32x4*)(SSk + (size_t)k * sskld);
        if constexpr (T == FOX)   { KT[k] = __builtin_amdgcn_rsqf(((s4[0] + s4[1]) + (s4[2] + s4[3])) * (1.f / 128.f) + NEPS); KT[2048 + k] = P.NEGC[(size_t)(b * 4 + h) * SEQ + k]; }
        if constexpr (T == DIFF)  { KT[k] = __builtin_amdgcn_rsqf((s4[0] + s4[1]) * (1.f / 64.f) + NEPS); KT[2048 + k] = __builtin_amdgcn_rsqf((s4[2] + s4[3]) * (1.f / 64.f) + NEPS); }
        if constexpr (T == CROSS) { const f32x4 s5 = *(const f32x4*)(SSk + (size_t)k * sskld + 4); KT[k] = __builtin_amdgcn_rsqf((((s4[0] + s4[1]) + (s4[2] + s4[3])) + ((s5[0] + s5[1]) + (s5[2] + s5[3]))) * (1.f / 256.f) + NEPS); }
    }
    int koff[2], voff[2];
#pragma unroll
    for (int i = 0; i < 2; ++i) { const int pi = 2 * wid + i;
        { const int row = pi * 4 + (lane >> 4), lc = (lane & 15) ^ (row & 7); koff[i] = row * kvpitch + lc * 8; }
        { const int st = pi * 2 + (lane >> 5), kk = (st >> 2) * 8 + ((lane >> 2) & 7), c = (st & 3) * 32 + (lane & 3) * 8;
          const int k = (kk & ~0xC) | ((kk & 4) << 1) | ((kk & 8) >> 1); voff[i] = k * kvpitch + c; } }
#define A_DMA(t, bf) do { const size_t to_ = (size_t)(t) * 64 * kvpitch; ALAS unsigned char* d_ = lds + (bf) * BUFSZ + wid * 2048; \
        _Pragma("unroll") for (int s_ = 0; s_ < KSUB; ++s_) { dma16(Kp + to_ + s_ * 128 + koff[0], d_ + s_ * SUBT); dma16(Kp + to_ + s_ * 128 + koff[1], d_ + s_ * SUBT + 1024); } \
        _Pragma("unroll") for (int s_ = 0; s_ < VSUB; ++s_) { dma16(Vp + to_ + s_ * 128 + voff[0], d_ + (KSUB + s_) * SUBT); dma16(Vp + to_ + s_ * 128 + voff[1], d_ + (KSUB + s_) * SUBT + 1024); } } while (0)
    A_DMA((T == FOX) ? NT - 1 : 0, 0);
    bf16x8 qr[NKS];
    {
        const int qrow = qlo + r32; float ssq; const bf16_t* qp;
        const size_t tok = (size_t)b * SEQ + qrow;
        if constexpr (T == FOX)  { const f32x4 s4 = *(const f32x4*)(P.SS + tok * 96 + 48 + 4 * h); ssq = ((s4[0] + s4[1]) + (s4[2] + s4[3])) * (1.f / 128.f); qp = P.PROJ + tok * PROJW + 1536 + h * 128; }
        if constexpr (T == DIFF) { const float* sp = P.SS + tok * 96 + 4 * h + 2 * sel; ssq = (sp[0] + sp[1]) * (1.f / 64.f); qp = P.PROJ + tok * PROJW + h * 128 + sel * 64; }
        if constexpr (T == CROSS){ const f32x4 s4 = *(const f32x4*)(P.SSQC + tok * 32 + 8 * h), s5 = *(const f32x4*)(P.SSQC + tok * 32 + 8 * h + 4);
                                   ssq = (((s4[0] + s4[1]) + (s4[2] + s4[3])) + ((s5[0] + s5[1]) + (s5[2] + s5[3]))) * (1.f / 256.f); qp = P.QC + tok * DM + h * 256; }
        const float rq = __builtin_amdgcn_rsqf(ssq + NEPS);
#pragma unroll
        for (int ks = 0; ks < NKS; ++ks) { const u32x4 raw = *(const u32x4*)(qp + ks * 16 + hi * 8); qr[ks] = qprep(raw, rq, GQ + ks * 16 + hi * 8); }
    }
    float qB = 0.f;
    if constexpr (T == FOX) { float s2 = 0.f;
#pragma unroll
        for (int ks = 0; ks < NKS; ++ks) { const u32x4 w = __builtin_bit_cast(u32x4, qr[ks]);
            s2 += (bflo(w.x) * bflo(w.x) + bfhi(w.x) * bfhi(w.x)) + (bflo(w.y) * bflo(w.y) + bfhi(w.y) * bfhi(w.y)) + (bflo(w.z) * bflo(w.z) + bfhi(w.z) * bfhi(w.z)) + (bflo(w.w) * bflo(w.w) + bfhi(w.w) * bfhi(w.w)); }
        { auto rr = __builtin_amdgcn_permlane32_swap(__float_as_uint(s2), __float_as_uint(s2), false, false); s2 = __uint_as_float(rr[0]) + __uint_as_float(rr[1]); }
        qB = 1.02f * sqrtf(128.f * s2); }
    ALAS int* dflag = (ALAS int*)(lds + KT_OFF_SELF + 16384);
    bool wdone = false;
    float m_reg = -1e30f, l_reg = 0.f; f32x16 o[4];
#pragma unroll
    for (int d = 0; d < 4; ++d) o[d] = f32x16{};
    const int vbl = v_rd_base(lane);
    for (int it = 0; it < NT; ++it) {
        const int t = (T == FOX) ? NT - 1 - it : it, cur = it & 1, kb = t * 64;
        asm volatile("s_waitcnt vmcnt(0)" ::: "memory");
        __syncthreads();
        if constexpr (T == FOX) { if (it > 0) { const ALAS int* fp = dflag + cur * 8; const int all = (fp[0] & fp[1] & fp[2] & fp[3]) & (fp[4] & fp[5] & fp[6] & fp[7]);
                if (__builtin_amdgcn_readfirstlane(all)) break; } }
        if (it + 1 < NT) A_DMA((T == FOX) ? t - 1 : t + 1, cur ^ 1);
        ALAS unsigned char* tb = lds + cur * BUFSZ;
        bool act;
        if constexpr (T == FOX)  act = (kb <= qlo + 31);
        if constexpr (T == DIFF) act = (t <= (qlo >> 6));
        if constexpr (T == CROSS) act = true;
        if (act && !wdone) {
            f32x16 p0 = f32x16{}, p1 = f32x16{};
            {
                const ALAS unsigned char* kt = tb + ((T == DIFF) ? sel * 128 : 0);
#pragma unroll
                for (int ks = 0; ks < NKS; ++ks) {
                    const int sub = ks >> 3, dd = ks & 7;
                    const ALAS unsigned char* a = kt + sub * SUBT + kswz(r32, ((dd & 3) * 16 + hi * 8) * 2) + (dd >> 2) * 128;
                    const bf16x8 b0 = *(const ALAS bf16x8*)a, b1 = *(const ALAS bf16x8*)(a + 32 * 256);
                    p0 = __builtin_amdgcn_mfma_f32_32x32x16_bf16(b0, qr[ks], p0, 0, 0, 0);
                    p1 = __builtin_amdgcn_mfma_f32_32x32x16_bf16(b1, qr[ks], p1, 0, 0, 0);
                }
            }
            {
                const ALAS float* rkp = KT + ((T == DIFF) ? sel * 2048 : 0) + kb + 4 * hi;
                const bool near = (T == DIFF) ? (kb + 63 - qlo > -128) : false;
                const ALAS float* btp = BT + (kb - qlo + BT_OFF + 4 * hi - r32);
                const float bfar = (T == DIFF) ? BT[0] : 0.f;
#pragma unroll
                for (int g = 0; g < 4; ++g) {
                    const f32x4 rk0 = *(const ALAS f32x4*)(rkp + 8 * g), rk1 = *(const ALAS f32x4*)(rkp + 32 + 8 * g);
                    f32x4 a0 = {0.f, 0.f, 0.f, 0.f}, a1 = {0.f, 0.f, 0.f, 0.f};
                    if constexpr (T == FOX)  { a0 = *(const ALAS f32x4*)(rkp + 2048 + 8 * g); a1 = *(const ALAS f32x4*)(rkp + 2048 + 32 + 8 * g); }
                    if constexpr (T == DIFF) { if (near) { a0 = (f32x4){btp[8 * g], btp[8 * g + 1], btp[8 * g + 2], btp[8 * g + 3]}; a1 = (f32x4){btp[32 + 8 * g], btp[33 + 8 * g], btp[34 + 8 * g], btp[35 + 8 * g]}; }
                                               else { a0 = (f32x4){bfar, bfar, bfar, bfar}; a1 = a0; } }
#pragma unroll
                    for (int e = 0; e < 4; ++e) { p0[4 * g + e] = __builtin_fmaf(p0[4 * g + e], rk0[e], a0[e]); p1[4 * g + e] = __builtin_fmaf(p1[4 * g + e], rk1[e], a1[e]); }
                }
                if constexpr (T == FOX) {
                    if (kb + 63 > qlo) {
                        const float NEG = -__builtin_inff(); const int dq = qlo + r32 - kb - 4 * hi;
#pragma unroll
                        for (int r = 0; r < 16; ++r) { const int c = (r & 3) + 8 * (r >> 2); if (c > dq) p0[r] = NEG; if (c + 32 > dq) p1[r] = NEG; }
                    }
                }
            }
            float alpha;
            {
                float pmax = p0[0];
#pragma unroll
                for (int r = 1; r < 16; ++r) pmax = fmaxf(pmax, p0[r]);
#pragma unroll
                for (int r = 0; r < 16; ++r) pmax = fmaxf(pmax, p1[r]);
                { auto rr = __builtin_amdgcn_permlane32_swap(__float_as_uint(pmax), __float_as_uint(pmax), false, false); pmax = fmaxf(__uint_as_float(rr[0]), __uint_as_float(rr[1])); }
                if (__builtin_expect(__all(pmax - m_reg <= THR), 1)) { alpha = 1.f; }
                else { const float mn = fmaxf(m_reg, pmax); alpha = __builtin_amdgcn_exp2f(m_reg - mn); m_reg = mn; }
#pragma unroll
                for (int r = 0; r < 16; ++r) { p0[r] = __builtin_amdgcn_exp2f(p0[r] - m_reg); p1[r] = __builtin_amdgcn_exp2f(p1[r] - m_reg); }
                float ps = 0.f;
#pragma unroll
                for (int r = 0; r < 16; ++r) ps += p0[r] + p1[r];
                { auto rr = __builtin_amdgcn_permlane32_swap(__float_as_uint(ps), __float_as_uint(ps), false, false); ps = __uint_as_float(rr[0]) + __uint_as_float(rr[1]); }
                l_reg = l_reg * alpha + ps;
            }
            bf16x8 pa0, pa1, pa2, pa3;
#define A_PK4(Pv, B_, OUT) do { unsigned a0_ = cvtpk(Pv[B_ + 0], Pv[B_ + 1]), a1_ = cvtpk(Pv[B_ + 2], Pv[B_ + 3]), b0_ = cvtpk(Pv[B_ + 4], Pv[B_ + 5]), b1_ = cvtpk(Pv[B_ + 6], Pv[B_ + 7]); \
        auto r0_ = __builtin_amdgcn_permlane32_swap(a0_, b0_, false, false); auto r1_ = __builtin_amdgcn_permlane32_swap(a1_, b1_, false, false); \
        u32x4 w_ = {r0_[0], r1_[0], r0_[1], r1_[1]}; OUT = __builtin_bit_cast(bf16x8, w_); } while (0)
            A_PK4(p0, 0, pa0); A_PK4(p0, 8, pa1); A_PK4(p1, 0, pa2); A_PK4(p1, 8, pa3);
#undef A_PK4
            if (__any(alpha < 1.f)) {
                if (hi == 0) wsf[r32] = alpha;
                asm volatile("s_waitcnt lgkmcnt(0)" ::: "memory");
#pragma unroll
                for (int r = 0; r < 16; ++r) { const float al = wsf[crow(r, hi)];
#pragma unroll
                    for (int d = 0; d < 4; ++d) o[d][r] *= al; }
            }
            {
                const int vb0 = (int)(unsigned)(size_t)(tb + (KSUB + ((T == CROSS) ? sel : 0)) * SUBT) + vbl;
#define A_TRRD(dst, off) asm volatile("ds_read_b64_tr_b16 %0, %1 offset:%2" : "=&v"(dst) : "v"(vb0), "i"(off) : "memory")
#define A_PV(d0) do { s16x4 l0, l1, l2, l3, h0, h1, h2, h3; constexpr int b_ = (d0) * 512; \
        A_TRRD(l0, b_); A_TRRD(h0, b_ + 2048); A_TRRD(l1, b_ + 4096); A_TRRD(h1, b_ + 6144); A_TRRD(l2, b_ + 8192); A_TRRD(h2, b_ + 10240); A_TRRD(l3, b_ + 12288); A_TRRD(h3, b_ + 14336); \
        asm volatile("s_waitcnt lgkmcnt(0)" ::: "memory"); ASBAR(); \
        o[d0] = __builtin_amdgcn_mfma_f32_32x32x16_bf16(pa0, (bf16x8){l0[0], l0[1], l0[2], l0[3], h0[0], h0[1], h0[2], h0[3]}, o[d0], 0, 0, 0); \
        o[d0] = __builtin_amdgcn_mfma_f32_32x32x16_bf16(pa1, (bf16x8){l1[0], l1[1], l1[2], l1[3], h1[0], h1[1], h1[2], h1[3]}, o[d0], 0, 0, 0); \
        o[d0] = __builtin_amdgcn_mfma_f32_32x32x16_bf16(pa2, (bf16x8){l2[0], l2[1], l2[2], l2[3], h2[0], h2[1], h2[2], h2[3]}, o[d0], 0, 0, 0); \
        o[d0] = __builtin_amdgcn_mfma_f32_32x32x16_bf16(pa3, (bf16x8){l3[0], l3[1], l3[2], l3[3], h3[0], h3[1], h3[2], h3[3]}, o[d0], 0, 0, 0); } while (0)
                A_PV(0); A_PV(1); A_PV(2); A_PV(3);
#undef A_PV
#undef A_TRRD
            }
        }
        if constexpr (T == FOX) { if (it + 1 < NT) {
                const float ub = qB + KT[2048 + kb - 1];
                if (__all(ub < m_reg - 40.f)) wdone = true;
                if (lane == 0) dflag[(cur ^ 1) * 8 + wid] = wdone ? 1 : 0; } }
    }
#undef A_DMA
    __syncthreads();
    if (hi == 0) wsf[32 + r32] = l_reg;
    asm volatile("s_waitcnt lgkmcnt(0)" ::: "memory");
#pragma unroll
    for (int r = 0; r < 16; ++r) { const float rl = __builtin_amdgcn_rcpf(wsf[32 + crow(r, hi)]);
#pragma unroll
        for (int d = 0; d < 4; ++d) o[d][r] *= rl; }
    if constexpr (T == DIFF) {
        ALAS float* hnd = (ALAS float*)lds + (size_t)rg * 4096 + lane;
        if (sel == 1) {
#pragma unroll
            for (int d = 0; d < 4; ++d)
#pragma unroll
                for (int r = 0; r < 16; ++r) hnd[(d * 16 + r) * 64] = o[d][r];
        }
        __syncthreads();
        if (sel == 0) {
#pragma unroll
            for (int d = 0; d < 4; ++d)
#pragma unroll
                for (int r = 0; r < 16; ++r) o[d][r] = o[d][r] - P.lam * hnd[(d * 16 + r) * 64];
        }
    }
    if (T == CROSS || sel == 0) {
        float gcol[4]; bf16_t* op;
        if constexpr (T == FOX)  { op = P.MIX + ((size_t)b * SEQ + qlo) * DM + 512 + h * 128;
#pragma unroll
            for (int d = 0; d < 4; ++d) gcol[d] = P.g_fox_out[32 * d + r32]; }
        if constexpr (T == DIFF) { op = P.MIX + ((size_t)b * SEQ + qlo) * DM + h * 128;
#pragma unroll
            for (int d = 0; d < 4; ++d) gcol[d] = P.g_subln[32 * d + r32] * P.one_m_lam_init; }
        if constexpr (T == CROSS){ op = P.CO + ((size_t)b * SEQ + qlo) * DM + h * 256 + sel * 128;
#pragma unroll
            for (int d = 0; d < 4; ++d) gcol[d] = 1.f; }
        ALAS bf16_t* stg = (ALAS bf16_t*)(lds + STG_OFF) + ((T == DIFF) ? rg : wid) * 4096;
#pragma unroll
        for (int r = 0; r < 16; ++r) {
            float rs = 1.f;
            if constexpr (T != CROSS) {
                float s = (o[0][r] * o[0][r] + o[1][r] * o[1][r]) + (o[2][r] * o[2][r] + o[3][r] * o[3][r]);
                s += __shfl_xor(s, 1); s += __shfl_xor(s, 2); s += __shfl_xor(s, 4); s += __shfl_xor(s, 8); s += __shfl_xor(s, 16);
                rs = __builtin_amdgcn_rsqf(s * (1.f / 128.f) + NEPS);
            }
            const int orow = crow(r, hi);
#pragma unroll
            for (int d = 0; d < 4; ++d) { const unsigned w = cvtpk(o[d][r] * rs * gcol[d], 0.f); stg[orow * 128 + 32 * d + r32] = (bf16_t)(w & 0xffffu); }
        }
        asm volatile("s_waitcnt lgkmcnt(0)" ::: "memory");
#pragma unroll
        for (int i = 0; i < 8; ++i) { const int row = i * 4 + (lane >> 4), ch = lane & 15; const u32x4 v = *(const ALAS u32x4*)(stg + row * 128 + ch * 8); *(u32x4*)(op + (size_t)row * DM + ch * 8) = v; }
    }
    __syncthreads();
}
#undef ASBAR
}
constexpr int NWAVES = 8, NTHR = NWAVES * 64;
constexpr int BATCH = 8, SEQ = 2048, DM = 1024, NTOK = BATCH * SEQ, NMEM = 256, MROWS = BATCH * NMEM;
constexpr int INCOLS = 3076, PROJW = 3072, NEXP = 16, DEXP = 512;
constexpr int SLOT_MAX = 2 * NTOK + NEXP * 256;
constexpr float EPS = 1e-6f, LOG2E = 1.4426950408889634f;
#ifndef MK_ONE_LAUNCH
#define MK_ONE_LAUNCH 1
#endif
#ifndef MK_PH_END
#define MK_PH_END 13
#endif
constexpr int N_PHASES = 13;
constexpr size_t MiB = 1u << 20, KiB = 1u << 10;
constexpr size_t WS_CTL = 0, CTL_ZERO_BYTES = 1 * MiB;
constexpr size_t WS_WIN = 2 * MiB, WS_WOUT = 8 * MiB, WS_WCQ = 10 * MiB, WS_WCKV = 12 * MiB, WS_WCO = 16 * MiB, WS_W1 = 18 * MiB, WS_W2 = 50 * MiB;
constexpr size_t WS_MEMN = 66 * MiB, WS_KVC = 70 * MiB, WS_SS = 78 * MiB, WS_H = 84 * MiB, WS_PROJ = 116 * MiB, WS_ACT = 204 * MiB, WS_SM = 248 * MiB, WS_END = 256 * MiB;
constexpr size_t WS_QC = WS_PROJ, WS_CO = WS_PROJ + 32 * MiB, WS_X1B = WS_PROJ + 64 * MiB;
constexpr size_t WS_X2B = 66 * MiB, WS_T = 98 * MiB, WS_TPERM = 130 * MiB, WS_Y = WS_TPERM, WS_SSX1 = WS_SS;
constexpr size_t WS_NEGC = WS_SM, WS_LOGF = WS_SM + 256 * KiB, WS_CHOICE = WS_SM + 512 * KiB, WS_SLOTTOK = WS_SM + 768 * KiB, WS_SLOTW = WS_SM + 928 * KiB,
                 WS_CHUNKCNT = WS_SM + 1088 * KiB, WS_MOESEG = WS_SM + 1104 * KiB, WS_TOKSLOT = WS_SM + 1152 * KiB, WS_SSKV = WS_SM + 2 * MiB, WS_SSQC = WS_SM + 3 * MiB;
static_assert(WS_TPERM + (size_t)SLOT_MAX * DM * 2 <= WS_ACT && WS_ACT + (size_t)SLOT_MAX * DEXP * 2 <= WS_SM && WS_SSQC + (size_t)NTOK * 32 * 4 <= WS_END && WS_X2B + 32 * MiB <= WS_T && WS_T + 32 * MiB <= WS_TPERM && WS_T + 32 * MiB <= WS_CO, "d_ws map");
constexpr int CW_TMO = 0, CW_QFOX = 64, CW_QDIFF = 128, CW_BAR = 4096;
constexpr int RING_BYTES = 133120;
constexpr int L_WSF = RING_BYTES, L_GQ = L_WSF + 2048, L_BT = L_GQ + 1024, L_MISC = L_BT + 4 * att::BT_N * 4, L_TILEE = L_MISC + 256, LDS_BYTES = 147456;
static_assert(RING_BYTES >= pg8::STAGE_BYTES && L_TILEE + 160 * 4 <= LDS_BYTES, "LDS map");

#define GAS __attribute__((address_space(1)))
#define LAS __attribute__((address_space(3)))
typedef unsigned short bf16;
typedef unsigned v4u __attribute__((ext_vector_type(4)));
typedef float f32x4 __attribute__((ext_vector_type(4)));
typedef short bf16x8 __attribute__((ext_vector_type(8)));
typedef GAS unsigned gu32;
typedef GAS unsigned long long gu64;
#define RLX_AGENT __ATOMIC_RELAXED, __HIP_MEMORY_SCOPE_AGENT
#define LDS_WAIT() asm volatile("s_waitcnt lgkmcnt(0)" ::: "memory")
#define VM_WAIT() asm volatile("s_waitcnt vmcnt(0)" ::: "memory")
__device__ __forceinline__ unsigned long long rt() { return __builtin_amdgcn_s_memrealtime(); }
__device__ __forceinline__ unsigned f2bf(float f) { unsigned u = __builtin_bit_cast(unsigned, f); return (u + 0x7fffu + ((u >> 16) & 1u)) >> 16; }
__device__ __forceinline__ unsigned pk2(float lo, float hi) { return f2bf(lo) | (f2bf(hi) << 16); }
#define XB_TMO      128
#define XB_XCNT(j)  (256  + 64 * (j))
#define XB_XSUB(j)  (1280 + 64 * (j))
#define XB_XGEN(j)  (2304 + 64 * (j))
#define XB_TOP      3328
#define XB_TOPGEN   3392
#define XCD_BAR_WORDS 3456
#define XB_SPIN_CAP (1u << 18)

__device__ __forceinline__ unsigned xb_ld(unsigned* p)              { return __hip_atomic_load(p, __ATOMIC_RELAXED, __HIP_MEMORY_SCOPE_AGENT); }
__device__ __forceinline__ unsigned xb_add(unsigned* p, unsigned v) { return __hip_atomic_fetch_add(p, v, __ATOMIC_RELAXED, __HIP_MEMORY_SCOPE_AGENT); }
__device__ __forceinline__ unsigned xb_xcc_id() { return (unsigned)__builtin_amdgcn_s_getreg((3 << 11) | 20) & 0xFu; }
#define XB_SPIN(cond, bar) do { unsigned _sp = 0; while (cond) { __builtin_amdgcn_s_sleep(1); \
    if ((++_sp & 255u) == 0u) { if (xb_ld(&(bar)[XB_TMO])) break; if (_sp > XB_SPIN_CAP) { atomicAdd(&(bar)[XB_TMO], 1u); break; } } } } while (0)

struct XcdBarrier {
    unsigned* bar; unsigned x;
    volatile LAS unsigned* st;
};

__device__ __forceinline__ XcdBarrier xcd_barrier_post(unsigned* bar, volatile LAS unsigned* st) {
    XcdBarrier b; b.bar = bar; b.x = xb_xcc_id(); b.st = st;
    if (threadIdx.x == 0) (void)xb_add(&bar[XB_XCNT(b.x)], 1u);
    return b;
}
__device__ __forceinline__ void xcd_barrier_complete(unsigned* bar, unsigned x, unsigned& nloc, unsigned& nx) {
    const unsigned G = gridDim.x * gridDim.y * gridDim.z;
    unsigned sum, cnt, mine, sp = 0u;
    for (;;) {
        sum = 0u; cnt = 0u; mine = 0u;
#pragma unroll
        for (unsigned j = 0; j < 16; ++j) { const unsigned c = xb_ld(&bar[XB_XCNT(j)]); sum += c; cnt += (c > 0u) ? 1u : 0u; mine = (j == x) ? c : mine; }
        if (sum == G) break;
        __builtin_amdgcn_s_sleep(1);
        if ((++sp & 255u) == 0u) { if (xb_ld(&bar[XB_TMO])) break; if (sp > XB_SPIN_CAP) { atomicAdd(&bar[XB_TMO], 1u); break; } }
    }
    nloc = mine > 0u ? mine : 1u; nx = cnt > 0u ? cnt : 1u;
}

__device__ __forceinline__ void xcd_barrier(const XcdBarrier& b) {
    asm volatile("s_waitcnt vmcnt(0)" ::: "memory");
    __syncthreads();
    if (threadIdx.x == 0) {
        unsigned* bar = b.bar;
        __builtin_amdgcn_s_waitcnt(0);
        unsigned nloc = b.st[0], nx = b.st[1];
        if (nloc == 0u) { xcd_barrier_complete(bar, b.x, nloc, nx); b.st[0] = nloc; b.st[1] = nx; }
        const unsigned old = xb_add(&bar[XB_XSUB(b.x)], 1u);
        const unsigned gen = old / nloc;
        if (old + 1u == (gen + 1u) * nloc) {
            __builtin_amdgcn_fence(__ATOMIC_RELEASE, "agent");
            asm volatile("s_waitcnt vmcnt(0)" ::: "memory");
            const unsigned og = xb_add(&bar[XB_TOP], 1u);
            const unsigned tg = og / nx;
            if (og + 1u == (tg + 1u) * nx) xb_add(&bar[XB_TOPGEN], 1u);
            else XB_SPIN(xb_ld(&bar[XB_TOPGEN]) == tg, bar);
            __builtin_amdgcn_fence(__ATOMIC_ACQUIRE, "agent");
            xb_add(&bar[XB_XGEN(b.x)], 1u);
            asm volatile("s_waitcnt vmcnt(0)" ::: "memory");
        } else {
            XB_SPIN(xb_ld(&bar[XB_XGEN(b.x)]) == gen, bar);
            __builtin_amdgcn_fence(__ATOMIC_ACQUIRE, "agent");
            asm volatile("s_waitcnt vmcnt(0)" ::: "memory");
        }
    }
    __syncthreads();
}

__device__ __forceinline__ float wave_sum(float v) {
#pragma unroll
    for (int o = 1; o < 64; o <<= 1) v += __shfl_xor(v, o);
    return v;
}
__device__ __forceinline__ void tr_item(const float* W, int ldw, int k0, int n0, bf16* WT, int drow0, int K, LAS float* scr, int lane, const float* kgain = nullptr) {
#pragma unroll 8
    for (int i = 0; i < 32; ++i) { const int kk = 2 * i + (lane >> 5); float w = W[(size_t)(k0 + kk) * ldw + n0 + (lane & 31)]; if (kgain) w *= kgain[k0 + kk]; scr[kk * 33 + (lane & 31)] = w; }
    LDS_WAIT(); asm volatile("" ::: "memory");
    const int c = lane & 7;
#pragma unroll
    for (int j = 0; j < 4; ++j) { const int n = (lane >> 3) + 8 * j; const LAS float* s = scr + (8 * c) * 33 + n;
        v4u o; o.x = pk2(s[0 * 33], s[1 * 33]); o.y = pk2(s[2 * 33], s[3 * 33]); o.z = pk2(s[4 * 33], s[5 * 33]); o.w = pk2(s[6 * 33], s[7 * 33]);
        *(GAS v4u*)(WT + (size_t)(drow0 + n) * K + k0 + 8 * c) = o; }
    LDS_WAIT(); asm volatile("" ::: "memory");
}
__device__ __forceinline__ float row_load_rstd(const float* xrow, int lane, f32x4 (&v)[4]) {
    const GAS f32x4* xr = (const GAS f32x4*)xrow + lane; float s = 0.f;
#pragma unroll
    for (int j = 0; j < 4; ++j) { v[j] = xr[64 * j]; s += (v[j].x * v[j].x + v[j].y * v[j].y) + (v[j].z * v[j].z + v[j].w * v[j].w); }
    return 1.0f / sqrtf(wave_sum(s) * (1.f / DM) + EPS);
}
__device__ __forceinline__ void row_store_bf16(bf16* orow, int lane, const f32x4 (&v)[4]) {
    GAS unsigned long long* o8 = (GAS unsigned long long*)orow + lane;
#pragma unroll
    for (int j = 0; j < 4; ++j) o8[64 * j] = (unsigned long long)pk2(v[j].x, v[j].y) | ((unsigned long long)pk2(v[j].z, v[j].w) << 32);
}
__device__ __forceinline__ int t5_bucket(int rel) {
    const int ret = rel > 0 ? 16 : 0, n = rel < 0 ? -rel : rel;
    int v;
    if (n < 8) v = n; else if (n < 12) v = 8; else if (n < 16) v = 9; else if (n < 23) v = 10; else if (n < 32) v = 11; else if (n < 46) v = 12; else if (n < 64) v = 13; else if (n < 91) v = 14; else v = 15;
    return ret + v;
}

struct Args { const float* in[32]; float* out; unsigned char* ws; int ph_lo, ph_hi, li, pad; };
__global__ void __launch_bounds__(NTHR, 2) mk_fwd(Args args) {
    extern __shared__ __attribute__((aligned(16))) unsigned char lds_raw[];
    LAS unsigned char* lds = (LAS unsigned char*)lds_raw;
    volatile LAS unsigned* MISC = (volatile LAS unsigned*)(lds + L_MISC);
    const int tid = threadIdx.x, lane = tid & 63, wave = __builtin_amdgcn_readfirstlane(tid >> 6);
    const int G = gridDim.x, bx = blockIdx.x;
    unsigned char* ws = args.ws;
    gu32* ctl = (gu32*)(ws + WS_CTL);
    float* out = args.out;
    bf16* W_IN = (bf16*)(ws + WS_WIN); bf16* W_OUT = (bf16*)(ws + WS_WOUT); bf16* W_CQ = (bf16*)(ws + WS_WCQ); bf16* W_CKV = (bf16*)(ws + WS_WCKV); bf16* W_CO = (bf16*)(ws + WS_WCO);
    bf16* W1 = (bf16*)(ws + WS_W1); bf16* W2 = (bf16*)(ws + WS_W2);
    bf16* MEMN = (bf16*)(ws + WS_MEMN); bf16* KVC = (bf16*)(ws + WS_KVC); float* SS = (float*)(ws + WS_SS); bf16* H = (bf16*)(ws + WS_H); bf16* PROJ = (bf16*)(ws + WS_PROJ);
    bf16* ACT = (bf16*)(ws + WS_ACT); bf16* QC = (bf16*)(ws + WS_QC); bf16* CO = (bf16*)(ws + WS_CO); bf16* TPERM = (bf16*)(ws + WS_TPERM);
    bf16* X1B = (bf16*)(ws + WS_X1B); bf16* X2B = (bf16*)(ws + WS_X2B); bf16* T = (bf16*)(ws + WS_T); float* SSX1 = (float*)(ws + WS_SSX1);
    float* NEGC = (float*)(ws + WS_NEGC); float* LOGF = (float*)(ws + WS_LOGF); float* SSKV = (float*)(ws + WS_SSKV); float* SSQC = (float*)(ws + WS_SSQC);
    int* CHOICE = (int*)(ws + WS_CHOICE); int* SLOTTOK = (int*)(ws + WS_SLOTTOK); float* SLOTW = (float*)(ws + WS_SLOTW); int* CHUNKCNT = (int*)(ws + WS_CHUNKCNT); int* MOESEG = (int*)(ws + WS_MOESEG); int* TOKSLOT = (int*)(ws + WS_TOKSLOT); bf16* Y = (bf16*)(ws + WS_Y);

    for (int u = tid; u < (LDS_BYTES - L_MISC) / 4; u += NTHR) ((LAS unsigned*)(lds + L_MISC))[u] = 0u;
    __syncthreads();
    XcdBarrier bar; bar.bar = (unsigned*)(ctl + CW_BAR) + args.li * XCD_BAR_WORDS; bar.x = 0; bar.st = nullptr;
    if (MK_ONE_LAUNCH) bar = xcd_barrier_post((unsigned*)(ctl + CW_BAR) + args.li * XCD_BAR_WORDS, MISC + 8);
    const int lo = args.ph_lo, hi = args.ph_hi;
#ifndef MK_PHMASK
#define MK_PHMASK 0x1FFF
#endif
#define IN(k) (((MK_PHMASK >> (k)) & 1) && lo <= (k) && (k) < hi)
#define SEAM(k) do { if (MK_ONE_LAUNCH && (k) + 1 < hi) xcd_barrier(bar); } while (0)

    if (IN(0)) {
        const int gw = bx * NWAVES + wave, NGW = G * NWAVES;
        LAS float* scr = (LAS float*)(lds + wave * 8704);
        LAS float* wf = (LAS float*)(lds + 73728);
        const float* w_in = args.in[4];
        for (int i = tid; i < 4096; i += NTHR) { const int k = i >> 2, j = i & 3; wf[j * 1024 + k] = w_in[(size_t)k * INCOLS + PROJW + j]; }
        constexpr int I_IN = 16 * 96, I_SQ = 16 * 32, I_CKV = 16 * 64, I_E = 16 * 256;
        constexpr int NITEMS = I_IN + 3 * I_SQ + I_CKV + 3 * I_E;
        for (int it = gw; it < NITEMS; it += NGW) {
            int r = it;
            if (r < I_IN) { tr_item(w_in, INCOLS, 64 * (r / 96), 32 * (r % 96), W_IN, 32 * (r % 96), DM, scr, lane); continue; } r -= I_IN;
            if (r < I_SQ) { tr_item(args.in[16], DM, 64 * (r / 32), 32 * (r % 32), W_OUT, 32 * (r % 32), DM, scr, lane); continue; } r -= I_SQ;
            if (r < I_SQ) { tr_item(args.in[19], DM, 64 * (r / 32), 32 * (r % 32), W_CQ, 32 * (r % 32), DM, scr, lane, args.in[17]); continue; } r -= I_SQ;
            if (r < I_SQ) { tr_item(args.in[23], DM, 64 * (r / 32), 32 * (r % 32), W_CO, 32 * (r % 32), DM, scr, lane); continue; } r -= I_SQ;
            if (r < I_CKV) { tr_item(args.in[20], 2 * DM, 64 * (r / 64), 32 * (r % 64), W_CKV, 32 * (r % 64), DM, scr, lane); continue; } r -= I_CKV;
            if (r < 2 * I_E) {
                const int up = r >= I_E ? 1 : 0; r -= up * I_E; const int e = r >> 8, q = r & 255, kb = q >> 4, nb = q & 15, c0 = 32 * nb;
                const float* src = (up ? args.in[30] : args.in[29]) + (size_t)e * DM * DEXP;
                tr_item(src, DEXP, 64 * kb, c0, W1, e * 1024 + (c0 >> 7) * 256 + up * 128 + (c0 & 127), DM, scr, lane); continue; } r -= 2 * I_E;
            { const int e = r >> 8, q = r & 255, kb = q >> 5, nb = q & 31;
              tr_item(args.in[31] + (size_t)e * DEXP * DM, DM, 64 * kb, 32 * nb, W2, e * 1024 + 32 * nb, DEXP, scr, lane); }
        }
        __syncthreads();
        {
            const float* x = args.in[0]; const float* g = args.in[3]; const float* bfg = args.in[5];
            f32x4 gv[4];
#pragma unroll
            for (int j = 0; j < 4; ++j) gv[j] = *((const GAS f32x4*)g + lane + 64 * j);
            for (int m = gw; m < NTOK; m += NGW) {
                f32x4 v[4]; const float rstd = row_load_rstd(x + (size_t)m * DM, lane, v);
                float d0 = 0.f, d1 = 0.f, d2 = 0.f, d3 = 0.f;
#pragma unroll
                for (int j = 0; j < 4; ++j) { v[j] = v[j] * rstd * gv[j];
                    const f32x4 w0 = *(const LAS f32x4*)(wf + 4 * lane + 256 * j), w1 = *(const LAS f32x4*)(wf + 1024 + 4 * lane + 256 * j), w2 = *(const LAS f32x4*)(wf + 2048 + 4 * lane + 256 * j), w3 = *(const LAS f32x4*)(wf + 3072 + 4 * lane + 256 * j);
                    d0 += (v[j].x * w0.x + v[j].y * w0.y) + (v[j].z * w0.z + v[j].w * w0.w); d1 += (v[j].x * w1.x + v[j].y * w1.y) + (v[j].z * w1.z + v[j].w * w1.w);
                    d2 += (v[j].x * w2.x + v[j].y * w2.y) + (v[j].z * w2.z + v[j].w * w2.w); d3 += (v[j].x * w3.x + v[j].y * w3.y) + (v[j].z * w3.z + v[j].w * w3.w); }
                row_store_bf16(H + (size_t)m * DM, lane, v);
                d0 = wave_sum(d0); d1 = wave_sum(d1); d2 = wave_sum(d2); d3 = wave_sum(d3);
                if (lane < 4) { const float z = (lane == 0 ? d0 : lane == 1 ? d1 : lane == 2 ? d2 : d3) + bfg[lane];
                    const float ls = fminf(z, 0.f) - log1pf(expf(-fabsf(z)));
                    LOGF[(size_t)((m >> 11) * 4 + lane) * SEQ + (m & (SEQ - 1))] = ls; }
            }
        }
        {
            const float* mem = args.in[1]; const float* g = args.in[18];
            f32x4 gv[4];
#pragma unroll
            for (int j = 0; j < 4; ++j) gv[j] = *((const GAS f32x4*)g + lane + 64 * j);
            for (int m = gw; m < MROWS; m += NGW) { f32x4 v[4]; const float rstd = row_load_rstd(mem + (size_t)m * DM, lane, v);
#pragma unroll
                for (int j = 0; j < 4; ++j) v[j] = v[j] * rstd * gv[j];
                row_store_bf16(MEMN + (size_t)m * DM, lane, v); }
        }
        SEAM(0);
    }

    if (IN(1)) {
        for (int bh = bx; bh < BATCH * 4; bh += G) {
            LAS float* wt = (LAS float*)lds;
            const f32x4 v = *(const f32x4*)(LOGF + (size_t)bh * SEQ + 4 * tid);
            const float c0 = v.x, c1 = c0 + v.y, c2 = c1 + v.z, c3 = c2 + v.w;
            float s = c3;
#pragma unroll
            for (int o = 1; o < 64; o <<= 1) { const float n = __shfl_up(s, o); if (lane >= o) s += n; }
            if (lane == 63) wt[wave] = s;
            __syncthreads();
            float base = s - c3;
            for (int w = 0; w < wave; ++w) base += wt[w];
            *(f32x4*)(NEGC + (size_t)bh * SEQ + 4 * tid) = (f32x4){-(base + c0) * LOG2E, -(base + c1) * LOG2E, -(base + c2) * LOG2E, -(base + c3) * LOG2E};
            __syncthreads();
        }
        { pg8::Gemm g{H, W_IN, NTOK, PROJW, DM}; pg8::StaticOrder S; S.init(NTOK, PROJW, G, bx);
          pg8::EpiBf16SS E{PROJ, PROJW, SS, 96, 0x3CFu, -1, nullptr, 0};
          pg8::gemm_phase<pg8::EpiBf16SS, pg8::StaticOrder, true, true>(lds, g, S, E); }
        SEAM(1);
    }

    if (IN(2)) {
        att::Ptrs P; P.PROJ = PROJ; P.SS = SS; P.NEGC = NEGC; P.QC = QC; P.SSQC = SSQC; P.KVC = KVC; P.SSKV = SSKV; P.MIX = H; P.CO = CO;
        P.g_fox_out = args.in[15]; P.g_subln = args.in[12];
        { float a = args.in[8][lane] * args.in[9][lane], c = args.in[10][lane] * args.in[11][lane]; a = wave_sum(a); c = wave_sum(c);
          const float lam_init = 0.8f - 0.6f; P.lam = expf(a) - expf(c) + lam_init; P.one_m_lam_init = 1.0f - lam_init; }
        LAS float* wsf = (LAS float*)(lds + L_WSF) + wave * 64; LAS float* GQ = (LAS float*)(lds + L_GQ); LAS float* BT = (LAS float*)(lds + L_BT);
        { pg8::Gemm g{MEMN, W_CKV, MROWS, 2 * DM, DM}; pg8::StaticOrder S; S.init(MROWS, 2 * DM, G, bx);
          pg8::EpiBf16SS E{KVC, 2 * DM, SSKV, 64, 0x0Fu, -1, nullptr, 0};
          pg8::gemm_phase<pg8::EpiBf16SS, pg8::StaticOrder, true, true>(lds, g, S, E); }
        if (tid < 128) GQ[tid] = args.in[13][tid] * args.in[14][tid] * (0.08838834764831845f * LOG2E);
        __syncthreads();
        for (;;) {
            if (tid == 0) MISC[0] = __hip_atomic_fetch_add(ctl + CW_QFOX + 256 * args.li, 1u, RLX_AGENT);
            __syncthreads();
            const int it = (int)MISC[0];
            __syncthreads();
            if (it >= 256) break;
            const int blk = 7 - (it >> 5), bh = it & 31;
#ifndef MK_NO_FOX
            att::attn_unit<att::FOX>(P, bh >> 2, bh & 3, blk, lds, wsf, GQ, BT);
#endif
        }
        __syncthreads();
        if (tid < 64) GQ[tid] = args.in[6][tid] * args.in[7][tid] * (0.125f * LOG2E);
        for (int i = tid; i < 4 * att::BT_N; i += NTHR) { const int hh = i / att::BT_N, rel = i % att::BT_N - att::BT_OFF; BT[i] = args.in[2][t5_bucket(rel) * 4 + hh] * LOG2E; }
        __syncthreads();
        for (;;) {
            if (tid == 0) MISC[0] = __hip_atomic_fetch_add(ctl + CW_QDIFF + 256 * args.li, 1u, RLX_AGENT);
            __syncthreads();
            const int it = (int)MISC[0];
            __syncthreads();
            if (it >= 512) break;
            const int blk = 15 - (it >> 5), bh = it & 31;
#ifndef MK_NO_DIFF
            att::attn_unit<att::DIFF>(P, bh >> 2, bh & 3, blk, lds, wsf, GQ, BT + (bh & 3) * att::BT_N);
#endif
        }
        SEAM(2);
    }

    if (IN(3)) {
        pg8::Gemm g{H, W_OUT, NTOK, DM, DM}; pg8::StaticOrder S; S.init(NTOK, DM, G, bx);
        pg8::EpiResBf16 E{args.in[0], nullptr, X1B, DM, SSX1, 32};
        pg8::gemm_phase<pg8::EpiResBf16, pg8::StaticOrder, true, true>(lds, g, S, E);
        SEAM(3);
    }


    if (IN(5)) {
        pg8::Gemm g{X1B, W_CQ, NTOK, DM, DM}; pg8::StaticOrder S; S.init(NTOK, DM, G, bx);
        LAS float* rsl = (LAS float*)(lds + L_BT);
        { pg8::Unit u;
          _Pragma("unroll") for (int i = 0; i < 4; ++i) if (S.next(i, u)) { const float* sp = SSX1 + (size_t)(u.pm * 256 + (tid >> 1)) * 32 + (tid & 1) * 16;
              const f32x4 a = *(const f32x4*)sp, b = *(const f32x4*)(sp + 4), c = *(const f32x4*)(sp + 8), d = *(const f32x4*)(sp + 12);
              float s = (((a.x + a.y) + (a.z + a.w)) + ((b.x + b.y) + (b.z + b.w))) + (((c.x + c.y) + (c.z + c.w)) + ((d.x + d.y) + (d.z + d.w)));
              s += __shfl_xor(s, 1);
              if ((tid & 1) == 0) rsl[i * 256 + (tid >> 1)] = 1.0f / sqrtf(s * (1.f / DM) + EPS); } }
        __syncthreads();
        pg8::EpiBf16SS E{QC, DM, SSQC, 32, 0xFu, -1, rsl, 0};
        pg8::gemm_phase<pg8::EpiBf16SS, pg8::StaticOrder, true, true>(lds, g, S, E);
        SEAM(5);
    }

    if (IN(6)) {
        att::Ptrs P; P.PROJ = PROJ; P.SS = SS; P.NEGC = NEGC; P.QC = QC; P.SSQC = SSQC; P.KVC = KVC; P.SSKV = SSKV; P.MIX = H; P.CO = CO;
        P.g_fox_out = args.in[15]; P.g_subln = args.in[12]; P.lam = 0.f; P.one_m_lam_init = 1.f;
        LAS float* wsf = (LAS float*)(lds + L_WSF) + wave * 64; LAS float* GQ = (LAS float*)(lds + L_GQ); LAS float* BT = (LAS float*)(lds + L_BT);
        if (tid < 256) GQ[tid] = args.in[21][tid] * args.in[22][tid] * (0.0625f * LOG2E);
        __syncthreads();
        for (int it = bx; it < 512; it += G) { const int bh = it >> 4, blk = it & 15; att::attn_unit<att::CROSS>(P, bh >> 2, bh & 3, blk, lds, wsf, GQ, BT); }
        SEAM(6);
    }

    if (IN(7)) {
        pg8::Gemm g{CO, W_CO, NTOK, DM, DM}; pg8::StaticOrder S; S.init(NTOK, DM, G, bx);
        pg8::EpiResBf16 E{nullptr, X1B, X2B, DM, nullptr, 0};
        pg8::gemm_phase<pg8::EpiResBf16, pg8::StaticOrder, true, true>(lds, g, S, E);
        SEAM(7);
    }

    if (IN(8)) {
        LAS float* WR = (LAS float*)lds;
        LAS int* cntL = (LAS int*)(lds + 20 * 1024 * 4);
        for (int i = tid; i < 4096; i += NTHR) WR[(i & 3) * 1024 + (i >> 2)] = args.in[25][i];
        for (int i = tid; i < 16384; i += NTHR) WR[(4 + (i & 15)) * 1024 + (i >> 4)] = args.in[27][i];
        const float* g = args.in[24]; const float* bgr = args.in[26]; const float* ber = args.in[28];
        f32x4 gv[4];
#pragma unroll
        for (int j = 0; j < 4; ++j) gv[j] = *(const f32x4*)(g + (j >> 1) * 512 + 8 * lane + (j & 1) * 4);
        for (int c = bx; c < NTOK / 64; c += G) {
            if (tid < 16) cntL[tid] = 0;
            __syncthreads();
#pragma unroll 1
            for (int i4 = 0; i4 < 2; ++i4) {
                const int m0 = c * 64 + wave * 8 + i4 * 4;
                f32x4 v[4][4];
#pragma unroll
                for (int r = 0; r < 4; ++r) { const v4u a = *((const GAS v4u*)(X2B + (size_t)(m0 + r) * DM) + lane), b = *((const GAS v4u*)(X2B + (size_t)(m0 + r) * DM) + 64 + lane);
                    v[r][0] = (f32x4){__uint_as_float(a.x << 16), __uint_as_float(a.x & 0xffff0000u), __uint_as_float(a.y << 16), __uint_as_float(a.y & 0xffff0000u)};
                    v[r][1] = (f32x4){__uint_as_float(a.z << 16), __uint_as_float(a.z & 0xffff0000u), __uint_as_float(a.w << 16), __uint_as_float(a.w & 0xffff0000u)};
                    v[r][2] = (f32x4){__uint_as_float(b.x << 16), __uint_as_float(b.x & 0xffff0000u), __uint_as_float(b.y << 16), __uint_as_float(b.y & 0xffff0000u)};
                    v[r][3] = (f32x4){__uint_as_float(b.z << 16), __uint_as_float(b.z & 0xffff0000u), __uint_as_float(b.w << 16), __uint_as_float(b.w & 0xffff0000u)}; }
#pragma unroll
                for (int r = 0; r < 4; ++r) { float s = 0.f;
#pragma unroll
                    for (int j = 0; j < 4; ++j) s += (v[r][j].x * v[r][j].x + v[r][j].y * v[r][j].y) + (v[r][j].z * v[r][j].z + v[r][j].w * v[r][j].w);
                    const float rstd = 1.0f / sqrtf(wave_sum(s) * (1.f / DM) + EPS);
#pragma unroll
                    for (int j = 0; j < 4; ++j) v[r][j] = v[r][j] * rstd * gv[j];
                    v4u oa, ob; oa.x = pk2(v[r][0].x, v[r][0].y); oa.y = pk2(v[r][0].z, v[r][0].w); oa.z = pk2(v[r][1].x, v[r][1].y); oa.w = pk2(v[r][1].z, v[r][1].w);
                    ob.x = pk2(v[r][2].x, v[r][2].y); ob.y = pk2(v[r][2].z, v[r][2].w); ob.z = pk2(v[r][3].x, v[r][3].y); ob.w = pk2(v[r][3].z, v[r][3].w);
                    *((GAS v4u*)(T + (size_t)(m0 + r) * DM) + lane) = oa; *((GAS v4u*)(T + (size_t)(m0 + r) * DM) + 64 + lane) = ob; }
                float gl[4][4];
#pragma unroll
                for (int q = 0; q < 4; ++q) { float a0 = 0.f, a1 = 0.f, a2 = 0.f, a3 = 0.f;
#pragma unroll
                    for (int j = 0; j < 4; ++j) { const f32x4 w = *(const LAS f32x4*)(WR + q * 1024 + (j >> 1) * 512 + 8 * lane + (j & 1) * 4);
                        a0 += (v[0][j].x * w.x + v[0][j].y * w.y) + (v[0][j].z * w.z + v[0][j].w * w.w); a1 += (v[1][j].x * w.x + v[1][j].y * w.y) + (v[1][j].z * w.z + v[1][j].w * w.w);
                        a2 += (v[2][j].x * w.x + v[2][j].y * w.y) + (v[2][j].z * w.z + v[2][j].w * w.w); a3 += (v[3][j].x * w.x + v[3][j].y * w.y) + (v[3][j].z * w.z + v[3][j].w * w.w); }
                    gl[0][q] = wave_sum(a0) + bgr[q]; gl[1][q] = wave_sum(a1) + bgr[q]; gl[2][q] = wave_sum(a2) + bgr[q]; gl[3][q] = wave_sum(a3) + bgr[q]; }
#pragma unroll
                for (int r = 0; r < 4; ++r) {
                    int gi = 0; float gm = gl[r][0];
#pragma unroll
                    for (int q = 1; q < 4; ++q) if (gl[r][q] > gm) { gm = gl[r][q]; gi = q; }
                    float gs = 0.f;
#pragma unroll
                    for (int q = 0; q < 4; ++q) gs += expf(gl[r][q] - gm);
                    const float pg = 1.0f / gs;
                    gi = __builtin_amdgcn_readfirstlane(gi);
                    float el[4];
#pragma unroll
                    for (int q = 0; q < 4; ++q) { float a = 0.f; const LAS float* wp = WR + (4 + 4 * gi + q) * 1024 + 8 * lane;
#pragma unroll
                        for (int j = 0; j < 4; ++j) { const f32x4 w = *(const LAS f32x4*)(wp + (j >> 1) * 512 + (j & 1) * 4); a += (v[r][j].x * w.x + v[r][j].y * w.y) + (v[r][j].z * w.z + v[r][j].w * w.w); }
                        el[q] = wave_sum(a) + ber[4 * gi + q]; }
                    int i0 = 0; float mx0 = el[0];
#pragma unroll
                    for (int q = 1; q < 4; ++q) if (el[q] > mx0) { mx0 = el[q]; i0 = q; }
                    int i1 = -1; float mx1 = -__builtin_inff();
#pragma unroll
                    for (int q = 0; q < 4; ++q) if (q != i0 && el[q] > mx1) { mx1 = el[q]; i1 = q; }
                    const float e1 = expf(mx1 - mx0), w0 = pg / (1.0f + e1), w1 = pg * e1 / (1.0f + e1);
                    if (lane == 0) { const int ea = gi * 4 + i0, eb = gi * 4 + i1; *(int4*)(CHOICE + (size_t)(m0 + r) * 4) = make_int4(ea, eb, __float_as_int(w0), __float_as_int(w1));
                        __hip_atomic_fetch_add(cntL + ea, 1, __ATOMIC_RELAXED, __HIP_MEMORY_SCOPE_WORKGROUP); __hip_atomic_fetch_add(cntL + eb, 1, __ATOMIC_RELAXED, __HIP_MEMORY_SCOPE_WORKGROUP); }
                }
            }
            __syncthreads();
            if (tid < 16) CHUNKCNT[c * 16 + tid] = cntL[tid];
            __syncthreads();
        }
        SEAM(8);
    }

    if (IN(9)) {
        LAS int* cc = (LAS int*)lds;
        LAS int* tot = cc + 4096; LAS int* pre = tot + 16; LAS int* segs = pre + 16; LAS int* chL = segs + 16; LAS int* slotL = chL + 256;
        for (int i = tid; i < 4096; i += NTHR) cc[i] = CHUNKCNT[i];
        __syncthreads();
        if (tid < 16) { int s = 0; for (int c = 0; c < 256; ++c) s += cc[c * 16 + tid]; tot[tid] = s; }
        __syncthreads();
        if (tid < 16) { int st = 0; for (int e = 0; e < tid; ++e) st += (tot[e] + 255) & ~255; segs[tid] = st; }
        __syncthreads();
        if (bx == 0 && tid < 16) { MOESEG[2 * tid] = segs[tid]; MOESEG[2 * tid + 1] = tot[tid]; }
        for (int c = bx; c < NTOK / 64; c += G) {
            if (tid < 16) { int s = 0; for (int c2 = 0; c2 < c; ++c2) s += cc[c2 * 16 + tid]; pre[tid] = segs[tid] + s; }
            if (tid < 256) chL[tid] = CHOICE[(size_t)c * 256 + tid];
            __syncthreads();
            if (tid < 16) { int pos = pre[tid];
                for (int i = 0; i < 64; ++i) { if (chL[i * 4] == tid) slotL[i * 2] = pos++; if (chL[i * 4 + 1] == tid) slotL[i * 2 + 1] = pos++; } }
            __syncthreads();
            for (int i = 0; i < 8; ++i) { const int tl = wave * 8 + i, m = c * 64 + tl;
                const v4u a = *((const GAS v4u*)(T + (size_t)m * DM) + lane), b = *((const GAS v4u*)(T + (size_t)m * DM) + 64 + lane);
#pragma unroll
                for (int k = 0; k < 2; ++k) { const int slot = slotL[tl * 2 + k];
                    *((GAS v4u*)(TPERM + (size_t)slot * DM) + lane) = a; *((GAS v4u*)(TPERM + (size_t)slot * DM) + 64 + lane) = b;
                    if (lane == 0) { SLOTTOK[slot] = m; SLOTW[slot] = __int_as_float(chL[tl * 4 + 2 + k]); TOKSLOT[m * 2 + k] = slot; } } }
            __syncthreads();
        }
        SEAM(9);
    }

    if (IN(10) || IN(11)) {
        LAS int* tile_e = (LAS int*)(lds + L_TILEE);
        int nt = 0;
        for (int e = 0; e < NEXP; ++e) { const int t0 = MOESEG[2 * e] >> 8, n = (MOESEG[2 * e + 1] + 255) >> 8; if (tid < n) tile_e[t0 + tid] = e; nt += n; }
        __syncthreads();
        if (IN(10)) {
            pg8::Gemm g{TPERM, W1, SLOT_MAX, NEXP * 1024, DM}; pg8::MoeOrder S{nt, G, bx, tile_e};
            pg8::EpiMoe1 E{ACT, DEXP};
            pg8::gemm_phase<pg8::EpiMoe1, pg8::MoeOrder, true, true>(lds, g, S, E);
            SEAM(10);
        }
        if (IN(11)) {
            pg8::Gemm g{ACT, W2, SLOT_MAX, NEXP * 1024, DEXP}; pg8::MoeOrder S{nt, G, bx, tile_e};
            pg8::EpiBf16SS E{Y, DM, nullptr, 0, 0u, 3, nullptr, 0};
            pg8::gemm_phase<pg8::EpiBf16SS, pg8::MoeOrder, true, true>(lds, g, S, E);
            SEAM(11);
        }
    }

    if (IN(12)) {
        const int gw = bx * NWAVES + wave, NGW = G * NWAVES;
        for (int m = gw; m < NTOK; m += NGW) {
            const int4 ch = *(const int4*)(CHOICE + (size_t)m * 4); const int s0 = TOKSLOT[m * 2], s1 = TOKSLOT[m * 2 + 1];
            const float w0 = __int_as_float(ch.z), w1 = __int_as_float(ch.w);
            GAS f32x4* orow = (GAS f32x4*)(out + (size_t)m * DM) + lane; const GAS unsigned long long* xrow = (const GAS unsigned long long*)(X2B + (size_t)m * DM) + lane;
            const GAS unsigned long long* y0 = (const GAS unsigned long long*)(Y + (size_t)s0 * DM) + lane; const GAS unsigned long long* y1 = (const GAS unsigned long long*)(Y + (size_t)s1 * DM) + lane;
#pragma unroll
            for (int j = 0; j < 4; ++j) { const unsigned long long xb = xrow[64 * j]; const unsigned x0 = (unsigned)xb, x1 = (unsigned)(xb >> 32);
                f32x4 v = (f32x4){__uint_as_float(x0 << 16), __uint_as_float(x0 & 0xffff0000u), __uint_as_float(x1 << 16), __uint_as_float(x1 & 0xffff0000u)}; const unsigned long long a = y0[64 * j], b = y1[64 * j];
                const unsigned a0 = (unsigned)a, a1 = (unsigned)(a >> 32), b0 = (unsigned)b, b1 = (unsigned)(b >> 32);
                v.x += w0 * __uint_as_float(a0 << 16) + w1 * __uint_as_float(b0 << 16); v.y += w0 * __uint_as_float(a0 & 0xffff0000u) + w1 * __uint_as_float(b0 & 0xffff0000u);
                v.z += w0 * __uint_as_float(a1 << 16) + w1 * __uint_as_float(b1 << 16); v.w += w0 * __uint_as_float(a1 & 0xffff0000u) + w1 * __uint_as_float(b1 & 0xffff0000u);
                orow[64 * j] = v; }
        }
    }
#undef IN
#undef SEAM
}

extern "C" void kernel_launch(void* const* d_in, const int* in_sizes, int n_in, void* d_out, int out_size, void* d_ws, size_t ws_size, hipStream_t stream) {
    static int grid = 0;
    if (grid == 0) {
        if (n_in != 32 || out_size != NTOK * DM || ws_size < WS_END) { fprintf(stderr, "kernel_launch: unexpected shapes (n_in %d out %d ws %zu)\n", n_in, out_size, ws_size); grid = -1; return; }
        int dev = 0, cus = 0, per_cu = 0;
        if (hipGetDevice(&dev) != hipSuccess || hipDeviceGetAttribute(&cus, hipDeviceAttributeMultiprocessorCount, dev) != hipSuccess) { grid = -1; return; }
        if (hipFuncSetAttribute((const void*)mk_fwd, hipFuncAttributeMaxDynamicSharedMemorySize, LDS_BYTES) != hipSuccess) { fprintf(stderr, "kernel_launch: hipFuncSetAttribute failed\n"); grid = -1; return; }
        if (hipOccupancyMaxActiveBlocksPerMultiprocessor(&per_cu, (const void*)mk_fwd, NTHR, LDS_BYTES) != hipSuccess || per_cu < 1) { fprintf(stderr, "kernel_launch: occupancy query says %d\n", per_cu); }
        (void)hipGetLastError();
        grid = cus;
    }
    if (grid < 0) return;
    (void)hipMemsetAsync((char*)d_ws + WS_CTL, 0, CTL_ZERO_BYTES, stream);
    Args a{};
    for (int i = 0; i < 32; ++i) a.in[i] = (const float*)d_in[i];
    a.out = (float*)d_out; a.ws = (unsigned char*)d_ws;
#if defined(MK_REP)
    a.ph_lo = 0; a.ph_hi = MK_REP + 1; a.li = 0;
    hipLaunchKernelGGL(mk_fwd, dim3(grid), dim3(NTHR), LDS_BYTES, stream, a);
    a.ph_lo = MK_REP; a.ph_hi = MK_PH_END; a.li = 1;
    hipLaunchKernelGGL(mk_fwd, dim3(grid), dim3(NTHR), LDS_BYTES, stream, a);
#elif MK_ONE_LAUNCH
    a.ph_lo = 0; a.ph_hi = MK_PH_END;
    hipLaunchKernelGGL(mk_fwd, dim3(grid), dim3(NTHR), LDS_BYTES, stream, a);
#else
    for (int p = 0; p < MK_PH_END; ++p) { a.ph_lo = p; a.ph_hi = p + 1; hipLaunchKernelGGL(mk_fwd, dim3(grid), dim3(NTHR), LDS_BYTES, stream, a); }
#endif
}
```
